# Optimizing an MI355X kernel written in HIP

```python
import jax, jax.numpy as jnp
from jax import lax
import numpy as np

D_MODEL = 1024
BATCH = 8
SEQ = 2048
DEPTH = 1

HEAD_DIM = 64
SB_HEADS = 8
SA_HEADS = 8
SA_KV_HEADS = 2
IDX_HEADS = 8
IDX_DIM = 32
TOPK_MAX = 256
Q_BLOCK = 128
D_FF = 4 * D_MODEL
EPS = 1e-6

SB_W = SB_HEADS * HEAD_DIM
SA_QW = SA_HEADS * HEAD_DIM
SA_KVW = SA_KV_HEADS * HEAD_DIM
IDX_QW = IDX_HEADS * IDX_DIM
SPLIT_SIZES = (SB_W, SB_W, SB_W, SA_QW, SA_KVW, SA_KVW, IDX_QW, IDX_DIM, IDX_HEADS, D_MODEL, D_MODEL)
PROJ_W = SB_W * 3 + SA_QW + 2 * SA_KVW + IDX_QW + IDX_DIM + IDX_HEADS + 2 * D_MODEL

kernel_name = "hybrid_stickbreak_dsa_gated_block"


def _rmsnorm(x, g):
    xf = x.astype(jnp.float32)
    xf = xf * lax.rsqrt(jnp.mean(xf * xf, axis=-1, keepdims=True) + EPS)
    return (xf * g.astype(jnp.float32)).astype(x.dtype)


def _split_cols(p):
    offs = np.cumsum(SPLIT_SIZES)[:-1].tolist()
    return jnp.split(p, offs, axis=-1)


def _stick_breaking(q, k, v):
    B, S, H, D = q.shape
    nblk = S // Q_BLOCK
    scale = D ** -0.5
    key_pos = jnp.arange(S)

    def block(i):
        qb = lax.dynamic_slice_in_dim(q, i * Q_BLOCK, Q_BLOCK, axis=1)
        z = jnp.einsum('bthd,bshd->bhts', qb, k,
                       preferred_element_type=jnp.float32) * scale
        qpos = i * Q_BLOCK + jnp.arange(Q_BLOCK)
        causal = key_pos[None, :] < qpos[:, None]
        log_beta = jax.nn.log_sigmoid(z)
        log_1mb = jnp.where(causal, jax.nn.log_sigmoid(-z), 0.0)
        later = lax.cumsum(log_1mb, axis=3, reverse=True) - log_1mb
        attn = jnp.where(causal, jnp.exp(log_beta + later), 0.0)
        return jnp.einsum('bhts,bshd->bthd', attn.astype(v.dtype), v)

    out = lax.map(block, jnp.arange(nblk))
    return out.transpose(1, 0, 2, 3, 4).reshape(B, S, H * D)


def _gather_rows(a, idx):
    return jax.vmap(lambda ab, ib: ab[ib])(a, idx)


def _dsa_attention(q, k, v, q_idx, k_idx, w_idx, slopes, top_k):
    B, S, Hq, D = q.shape
    Hkv = k.shape[2]
    G = Hq // Hkv
    Hi, Di = q_idx.shape[2], q_idx.shape[3]
    nblk = S // Q_BLOCK
    key_pos = jnp.arange(S)
    slopes_g = slopes.reshape(Hkv, G)

    def block(i):
        start = i * Q_BLOCK
        qpos = start + jnp.arange(Q_BLOCK)
        qb = lax.dynamic_slice_in_dim(q, start, Q_BLOCK, axis=1)
        qib = lax.dynamic_slice_in_dim(q_idx, start, Q_BLOCK, axis=1)
        wb = lax.dynamic_slice_in_dim(w_idx, start, Q_BLOCK, axis=1)
        rel = jnp.einsum('bthd,bsd->bths', qib, k_idx,
                         preferred_element_type=jnp.float32) * (Di ** -0.5)
        score = jnp.einsum('bth,bths->bts', wb.astype(jnp.float32), jax.nn.relu(rel))
        score = jnp.where(key_pos[None, None, :] <= qpos[None, :, None], score, -jnp.inf)
        _, idx = lax.top_k(score, top_k)
        valid = idx <= qpos[None, :, None]
        k_sel = _gather_rows(k, idx)
        v_sel = _gather_rows(v, idx)
        qg = qb.reshape(B, Q_BLOCK, Hkv, G, D)
        s = jnp.einsum('btgrd,btkgd->btgrk', qg, k_sel,
                       preferred_element_type=jnp.float32) * (D ** -0.5)
        dist = (qpos[None, :, None] - idx).astype(jnp.float32)
        s = s - slopes_g[None, None, :, :, None] * dist[:, :, None, None, :]
        s = jnp.where(valid[:, :, None, None, :], s, -jnp.inf)
        p = jax.nn.softmax(s, axis=-1)
        o = jnp.einsum('btgrk,btkgd->btgrd', p.astype(v.dtype), v_sel)
        return o.reshape(B, Q_BLOCK, Hq * D)

    out = lax.map(block, jnp.arange(nblk))
    return out.transpose(1, 0, 2, 3).reshape(B, S, Hq * D)


def setup_inputs(seed: int = 0) -> dict:
    key = jax.random.key(seed)
    ks = jax.random.split(key, 16)
    L = DEPTH

    def nrm(k, shape, fan_in):
        return jax.random.normal(k, shape, jnp.float32) * (fan_in ** -0.5)

    def gain(k, shape):
        return 1.0 + 0.02 * jax.random.normal(k, shape, jnp.float32)

    return {
        "x": jax.random.normal(ks[0], (BATCH, SEQ, D_MODEL), jnp.float32),
        "norm_mix": gain(ks[1], (L, D_MODEL)),
        "w_in": nrm(ks[2], (L, D_MODEL, PROJ_W), D_MODEL),
        "q_norm_sb": gain(ks[3], (L, HEAD_DIM)),
        "k_norm_sb": gain(ks[4], (L, HEAD_DIM)),
        "q_norm_sa": gain(ks[5], (L, HEAD_DIM)),
        "k_norm_sa": gain(ks[6], (L, HEAD_DIM)),
        "w_branch_sb": nrm(ks[7], (L, SB_W, D_MODEL), SB_W),
        "w_branch_sa": nrm(ks[8], (L, SA_QW, D_MODEL), SA_QW),
        "w_out": nrm(ks[9], (L, D_MODEL, D_MODEL), D_MODEL),
        "norm_mlp": gain(ks[10], (L, D_MODEL)),
        "w_ff1": nrm(ks[11], (L, D_MODEL, D_FF), D_MODEL),
        "w_ff2": nrm(ks[12], (L, D_FF, D_MODEL), D_FF),
    }


def reference(x, norm_mix, w_in, q_norm_sb, k_norm_sb, q_norm_sa, k_norm_sa,
              w_branch_sb, w_branch_sa, w_out, norm_mlp, w_ff1, w_ff2):
    B, S, _ = x.shape
    top_k = min(TOPK_MAX, S // 4)
    slopes = jnp.exp2(-8.0 * jnp.arange(1, SA_HEADS + 1, dtype=jnp.float32) / SA_HEADS)

    for l in range(DEPTH):
        h = _rmsnorm(x, norm_mix[l])
        proj = h @ w_in[l]
        (q_sb, k_sb, v_sb, q_sa, k_sa, v_sa,
         q_ix, k_ix, w_ix, g_sb, g_sa) = _split_cols(proj)

        q_sb = _rmsnorm(q_sb.reshape(B, S, SB_HEADS, HEAD_DIM), q_norm_sb[l])
        k_sb = _rmsnorm(k_sb.reshape(B, S, SB_HEADS, HEAD_DIM), k_norm_sb[l])
        v_sb = v_sb.reshape(B, S, SB_HEADS, HEAD_DIM)
        o_sb = _stick_breaking(q_sb, k_sb, v_sb)

        q_sa = _rmsnorm(q_sa.reshape(B, S, SA_HEADS, HEAD_DIM), q_norm_sa[l])
        k_sa = _rmsnorm(k_sa.reshape(B, S, SA_KV_HEADS, HEAD_DIM), k_norm_sa[l])
        v_sa = v_sa.reshape(B, S, SA_KV_HEADS, HEAD_DIM)
        q_ix = q_ix.reshape(B, S, IDX_HEADS, IDX_DIM)
        w_ix = w_ix * (IDX_HEADS ** -0.5)
        o_sa = _dsa_attention(q_sa, k_sa, v_sa, q_ix, k_ix, w_ix, slopes, top_k)

        merged = (jax.nn.sigmoid(g_sb) * (o_sb @ w_branch_sb[l])
                  + jax.nn.sigmoid(g_sa) * (o_sa @ w_branch_sa[l]))
        x = x + merged @ w_out[l]

        h2 = _rmsnorm(x, norm_mlp[l])
        x = x + jnp.square(jax.nn.relu(h2 @ w_ff1[l])) @ w_ff2[l]

    return x
```

```cpp
#include <hip/hip_runtime.h>
#include <cstdio>
#include <cstdint>

#ifndef MK_DEBUG
#define MK_DEBUG 0
#endif

#define LAS __attribute__((address_space(3)))
#define GAS __attribute__((address_space(1)))
typedef unsigned short bf16_t;
typedef short bf16x8 __attribute__((ext_vector_type(8)));
typedef short s16x4 __attribute__((ext_vector_type(4)));
typedef float f32x4 __attribute__((ext_vector_type(4)));
typedef float f32x16 __attribute__((ext_vector_type(16)));
typedef unsigned u32x4 __attribute__((ext_vector_type(4)));
typedef unsigned u32x2 __attribute__((ext_vector_type(2)));
typedef float f32x2_t __attribute__((ext_vector_type(2)));
typedef __bf16 bf16x2_t __attribute__((ext_vector_type(2)));
typedef short v4i16_t __attribute__((ext_vector_type(4)));

__device__ __forceinline__ unsigned cvtpk(float lo, float hi) { f32x2_t v = {lo, hi}; bf16x2_t b = __builtin_convertvector(v, bf16x2_t); return __builtin_bit_cast(unsigned, b); }
typedef int i32x8 __attribute__((ext_vector_type(8)));
__device__ __forceinline__ unsigned pk4_fp8_nc(float a, float b, float c, float d) { int v = __builtin_amdgcn_cvt_pk_fp8_f32(a, b, 0, false); v = __builtin_amdgcn_cvt_pk_fp8_f32(c, d, v, true); return (unsigned)v; }
__device__ __forceinline__ unsigned pk4_fp8(float a, float b, float c, float d) {
    a = __builtin_amdgcn_fmed3f(a, -448.f, 448.f); b = __builtin_amdgcn_fmed3f(b, -448.f, 448.f); c = __builtin_amdgcn_fmed3f(c, -448.f, 448.f); d = __builtin_amdgcn_fmed3f(d, -448.f, 448.f);
    int v = __builtin_amdgcn_cvt_pk_fp8_f32(a, b, 0, false); v = __builtin_amdgcn_cvt_pk_fp8_f32(c, d, v, true); return (unsigned)v; }
__device__ __forceinline__ float bf2f(unsigned short h) { return __uint_as_float((unsigned)h << 16); }
__device__ __forceinline__ float bflo(unsigned w) { return __uint_as_float(w << 16); }
__device__ __forceinline__ float bfhi(unsigned w) { return __uint_as_float(w & 0xffff0000u); }

constexpr int NB = 8, SEQ = 2048, DM = 1024, FF = 4096, M = NB * SEQ;
constexpr int PROJ_W = 4648, NPROJ = 4864;
constexpr float EPS = 1e-6f;
constexpr float C2 = 0.125f * 1.4426950408889634f;
constexpr int OFF_QSB = 0, OFF_KSB = 512, OFF_VSB = 1024, OFF_QSA = 1536, OFF_KSA = 2048, OFF_VSA = 2176,
              OFF_QIX = 2304, OFF_KIX = 2560, OFF_WIX = 2592, OFF_GSB = 2600, OFF_GSA = 3624;

constexpr size_t MiB = 1u << 20;
constexpr size_t WS_CTL = 0, CTL_ZERO_BYTES = 1 * MiB;
constexpr size_t WS_WIN = 2 * MiB, WS_WCAT = 12 * MiB, WS_WOUT = 14 * MiB, WS_W1 = 16 * MiB, WS_W2 = 24 * MiB;
constexpr size_t WS_XN = 32 * MiB;
constexpr size_t WS_QSB = 64 * MiB, WS_KSB = 80 * MiB, WS_VSB = 96 * MiB, WS_QSA = 112 * MiB;
constexpr size_t WS_KSA = 128 * MiB, WS_VSA = 132 * MiB;
constexpr size_t WS_QIX = 136 * MiB, WS_KIX = 144 * MiB, WS_WIX = 145 * MiB;
constexpr size_t WS_MASK = 146 * MiB;
constexpr size_t WS_G1 = 152 * MiB, WS_G2 = 184 * MiB;
constexpr size_t WS_OCAT = 216 * MiB;
constexpr size_t WS_XN8 = 216 * MiB;
constexpr size_t WS_WG8 = 250 * MiB;
__host__ __device__ __forceinline__ int tile_a(int t) { return t < 4 ? t : (t < 6 ? t + 2 : t + 3); }
__host__ __device__ __forceinline__ int tile_b(int t) { return t < 2 ? t + 4 : (t == 2 ? 8 : t + 8); }
constexpr int NPROJ_A = 2048, NGATE = 2816;
constexpr float O_SCALE = 4.f, WCAT_SCALE = 16.f;
constexpr float X1_SCALE = 2.f, W1_SCALE = 32.f;
constexpr size_t WS_X18 = 152 * MiB;
constexpr float U_SCALE = 8.f, W2_SCALE = 64.f;
constexpr float MG_SCALE = 4.f, WOUT_SCALE = 32.f;
constexpr float GATE_WSCALE = 32.f;
constexpr size_t WS_RSTD = 249 * MiB;
constexpr size_t WS_SSQ = 248 * MiB;
constexpr size_t WS_MG = 128 * MiB;
constexpr size_t WS_U = 64 * MiB;
constexpr size_t WS_END = 256 * MiB;
constexpr int CW_BAR = 4096;
constexpr int CW_XCC = 16384;
constexpr int CW_WINREADY = 20608;
constexpr int CW_MFLAG = 32768;

namespace pg8 {
constexpr int BM = 256, BK = 64, HALF = 128, HTB = HALF * BK * 2, STAGE_BYTES = 8 * HTB, NXCD = 8, WGM = 8;
__host__ __device__ __forceinline__ int lds_byte(int r, int c) { const int st = (r >> 4) * 2 + (c >> 5), rr = r & 15, cc = c & 31, ob = rr * 64 + cc * 2; return st * 1024 + (ob ^ (((ob >> 9) & 1) << 5)); }
__host__ __device__ __forceinline__ void stage_rc(int b, int& R, int& C) { const int st = b / 1024, sb = b % 1024, swz = sb ^ (((sb >> 9) & 1) << 5); R = (st >> 1) * 16 + swz / 64; C = (st & 1) * 32 + (swz % 64) / 2; }
__host__ __device__ __forceinline__ int perm32(int rho) { const int n = rho >> 4, i = rho & 15; return 8 * (i >> 2) + 4 * n + (i & 3); }

struct Unit { int pm, pn; };
struct Gemm { const bf16_t* A; const bf16_t* Bt; int M, N, K; };
struct StaticOrder {
    int nM, nN, nwg, G, c, dup;
    __host__ __device__ void init(int M_, int N_, int G_, int c_, int dup_ = 1) { nM = M_ / BM; nN = N_ / BM; nwg = nM * nN; G = G_; c = c_; dup = dup_; }
    __host__ __device__ __forceinline__ bool next(int i, Unit& u) const {
        const long L = (long)i * G + c; if (L >= (long)nwg * dup) return false;
        int wgid = (int)(L % nwg); { const int q = nwg / NXCD, r = nwg % NXCD, xcd = wgid % NXCD, off = wgid / NXCD; wgid = (xcd < r ? xcd * (q + 1) : r * (q + 1) + (xcd - r) * q) + off; }
        const int nig = WGM * nN, gid = wgid / nig, fm = gid * WGM, gsz = (nM - fm) < WGM ? (nM - fm) : WGM;
        u.pm = fm + ((wgid % nig) % gsz); u.pn = (wgid % nig) / gsz; return true;
    }
};

template <class Epi, class Sched, bool ALIGN_EPI, bool FP8 = false>
__device__ __forceinline__ void gemm_phase(LAS unsigned char* lds, const Gemm g, const Sched& S, const Epi& E) {
    const int tid = threadIdx.x, wid = __builtin_amdgcn_readfirstlane(tid >> 6), lane = tid & 63, wr = wid >> 2, wc = wid & 3, fr = lane & 15, fq = lane >> 4;
    const int K = FP8 ? g.K / 2 : g.K, nt = K / BK;
    unsigned voffA[2], voffB[2];
#pragma unroll
    for (int i = 0; i < 2; ++i) { int R, C; stage_rc(tid * 16 + i * 8192, R, C); const int Rb = 64 * (R >> 5) + perm32(R & 31);
        voffA[i] = (unsigned)(R * K + C) * 2u; voffB[i] = (unsigned)(Rb * K + C) * 2u; }
    const size_t kstep = (size_t)(BK * 2);
    const size_t hstep = (size_t)HALF * K * 2;
    const size_t hstepB = (size_t)32 * K * 2;
    const size_t tstep = 2 * hstep;
    const unsigned ldsw = (unsigned)wid * 1024u;
    const int aoff = lds_byte(wr * 64 + fr, fq * 8), boff = lds_byte(wc * 32 + fr, fq * 8);
    const int aoff2 = 1024, boff2 = 1024;
#define PG8_SA(b, h) (((b) * 2 + (h)) * HTB)
#define PG8_SB(b, h) ((4 + (b) * 2 + (h)) * HTB)
#define PG8_STAGE(bufoff, gbase, voff) do { _Pragma("unroll") for (int _i = 0; _i < 2; ++_i) \
        __builtin_amdgcn_global_load_lds((const unsigned*)((const char*)(gbase) + (voff)[_i]), (LAS unsigned*)(lds + (bufoff) + ldsw + _i * 8192), 16, 0, 0); } while (0)
#define PG8_LD8(base) __builtin_bit_cast(i32x8, __builtin_shufflevector(*(const LAS bf16x8*)(lds + (base)), *(const LAS bf16x8*)(lds + (base) + aoffB2_), 0, 1, 2, 3, 4, 5, 6, 7, 8, 9, 10, 11, 12, 13, 14, 15))
#define PG8_LDA(dst, b, h) do { if constexpr (FP8) { const int aoffB2_ = aoff2; _Pragma("unroll") for (int m = 0; m < 4; ++m) dst##8[m] = PG8_LD8(PG8_SA(b, h) + aoff + m * 2048); } \
        else { _Pragma("unroll") for (int m = 0; m < 4; ++m) _Pragma("unroll") for (int k = 0; k < 2; ++k) dst[m][k] = *(const LAS bf16x8*)(lds + PG8_SA(b, h) + aoff + m * 2048 + k * 1024); } } while (0)
#define PG8_LDB(dst, b, h) do { if constexpr (FP8) { const int aoffB2_ = boff2; _Pragma("unroll") for (int n = 0; n < 2; ++n) dst##8[n] = PG8_LD8(PG8_SB(b, h) + boff + n * 2048); } \
        else { _Pragma("unroll") for (int n = 0; n < 2; ++n) _Pragma("unroll") for (int k = 0; k < 2; ++k) dst[n][k] = *(const LAS bf16x8*)(lds + PG8_SB(b, h) + boff + n * 2048 + k * 1024); } } while (0)
#define PG8_MMA(ai, bj, At, Bt) do { __builtin_amdgcn_s_setprio(1); _Pragma("unroll") for (int m = 0; m < 4; ++m) _Pragma("unroll") for (int n = 0; n < 2; ++n) { \
        if constexpr (FP8) asm volatile("v_mfma_f32_16x16x128_f8f6f4 %0, %1, %2, %0" : "+v"(acc[ai][bj][m][n]) : "v"(Bt##8[n]), "v"(At##8[m]));   \
        else { _Pragma("unroll") for (int k = 0; k < 2; ++k) acc[ai][bj][m][n] = __builtin_amdgcn_mfma_f32_16x16x32_bf16(Bt[n][k], At[m][k], acc[ai][bj][m][n], 0, 0, 0); } } \
        __builtin_amdgcn_s_setprio(0); } while (0)
#define PG8_WAIT_V(n) asm volatile("s_waitcnt vmcnt(" #n ")" ::: "memory")
#define PG8_WAIT_L(n) asm volatile("s_waitcnt lgkmcnt(" #n ")" ::: "memory")
#define PG8_BAR __builtin_amdgcn_s_barrier()
#define PG8_SCHED __builtin_amdgcn_sched_barrier(0)
    Unit cur, nxt; int ui = 0;
    if (!S.next(0, cur)) return;
    f32x4 acc[2][2][4][2];
    E.init(acc, cur, wr, wc, fr, fq);
    bf16x8 At[4][2], B0[2][2], B1[2][2]; i32x8 At8[4], B08[2], B18[2];
    const char* cA = (const char*)g.A + (size_t)cur.pm * tstep; const char* cB = (const char*)g.Bt + (size_t)cur.pn * tstep;
    PG8_STAGE(PG8_SB(0, 0), cB, voffB); PG8_STAGE(PG8_SB(0, 1), cB + hstepB, voffB); PG8_STAGE(PG8_SA(0, 0), cA, voffA); PG8_STAGE(PG8_SA(0, 1), cA + hstep, voffA);
    if (wr == 1) PG8_BAR;
    PG8_WAIT_V(2); PG8_BAR;
    PG8_STAGE(PG8_SB(1, 0), cB + kstep, voffB); PG8_STAGE(PG8_SA(1, 0), cA + kstep, voffA); PG8_STAGE(PG8_SB(1, 1), cB + hstepB + kstep, voffB);
    PG8_WAIT_V(6); PG8_BAR;
    for (;;) {
        const bool has_next = S.next(ui + 1, nxt);
        const char* nA = has_next ? (const char*)g.A + (size_t)nxt.pm * tstep : cA; const char* nB = has_next ? (const char*)g.Bt + (size_t)nxt.pn * tstep : cB;
#pragma unroll 1
        for (int t = 0; t < nt; t += 2) {
            const bool last = (t == nt - 2);
            const char* a1 = cA + (size_t)(t + 1) * kstep;
            const char* a2 = last ? nA : cA + (size_t)(t + 2) * kstep; const char* b2 = last ? nB : cB + (size_t)(t + 2) * kstep;
            const char* a3 = a2 + kstep; const char* b3 = b2 + kstep;
            if constexpr (Epi::MID_T > 0) { if (t == Epi::MID_T) E.mid(acc, cur, wr, wc, fr, fq); }
            PG8_LDB(B0, 0, 0); PG8_LDB(B1, 0, 1); PG8_SCHED; PG8_LDA(At, 0, 0); PG8_STAGE(PG8_SA(1, 1), a1 + hstep, voffA);
            PG8_WAIT_V(8); PG8_WAIT_L(0); PG8_BAR; PG8_MMA(0, 0, At, B0); PG8_MMA(0, 1, At, B1); PG8_BAR; PG8_SCHED;
            PG8_LDA(At, 0, 1); PG8_STAGE(PG8_SB(0, 0), b2, voffB); PG8_STAGE(PG8_SB(0, 1), b2 + hstepB, voffB); PG8_STAGE(PG8_SA(0, 0), a2, voffA);
            PG8_WAIT_V(8); PG8_WAIT_L(0); PG8_BAR; PG8_MMA(1, 0, At, B0); PG8_MMA(1, 1, At, B1); PG8_BAR; PG8_SCHED;
            PG8_LDB(B0, 1, 0); PG8_LDB(B1, 1, 1); PG8_SCHED; PG8_LDA(At, 1, 0); PG8_STAGE(PG8_SA(0, 1), a2 + hstep, voffA);
            PG8_WAIT_V(8); PG8_WAIT_L(0); PG8_BAR; PG8_MMA(0, 0, At, B0); PG8_MMA(0, 1, At, B1); PG8_BAR; PG8_SCHED;
            PG8_LDA(At, 1, 1); PG8_STAGE(PG8_SB(1, 0), b3, voffB); PG8_STAGE(PG8_SB(1, 1), b3 + hstepB, voffB); PG8_STAGE(PG8_SA(1, 0), a3, voffA);
            PG8_WAIT_V(8); PG8_WAIT_L(0); PG8_BAR; PG8_MMA(1, 0, At, B0); PG8_MMA(1, 1, At, B1); PG8_BAR; PG8_SCHED;
        }
        if constexpr (ALIGN_EPI) { if (wr == 0) PG8_BAR; }
        if constexpr (FP8) asm volatile("s_nop 15\n\ts_nop 15" ::: "memory");
        E(acc, cur, wr, wc, fr, fq);
        if (!has_next) break;
        E.init(acc, nxt, wr, wc, fr, fq);
        cur = nxt; cA = nA; cB = nB; ++ui;
        if constexpr (ALIGN_EPI) { if (wr == 1) PG8_BAR; }
    }
    PG8_WAIT_V(0);
    if constexpr (!ALIGN_EPI) { if (wr == 0) PG8_BAR; }
    PG8_BAR;
#undef PG8_SA
#undef PG8_SB
#undef PG8_STAGE
#undef PG8_LDA
#undef PG8_LDB
#undef PG8_MMA
#undef PG8_LD8
#undef PG8_WAIT_V
#undef PG8_WAIT_L
#undef PG8_BAR
#undef PG8_SCHED
}

typedef f32x4 Acc[2][2][4][2];
__device__ __forceinline__ u32x4 pack8(const f32x4 a, const f32x4 b) { u32x4 w; w.x = cvtpk(a[0], a[1]); w.y = cvtpk(a[2], a[3]); w.z = cvtpk(b[0], b[1]); w.w = cvtpk(b[2], b[3]); return w; }
__device__ __forceinline__ void unpack8(const u32x4 w, float (&f)[8]) { f[0] = bflo(w.x); f[1] = bfhi(w.x); f[2] = bflo(w.y); f[3] = bfhi(w.y); f[4] = bflo(w.z); f[5] = bfhi(w.z); f[6] = bflo(w.w); f[7] = bfhi(w.w); }

__device__ __forceinline__ unsigned gate_u8x4(const f32x4 g, float qmin) {
    const unsigned a = (unsigned)fmaxf(fmaf(g[0], 255.f, 0.5f), qmin), b = (unsigned)fmaxf(fmaf(g[1], 255.f, 0.5f), qmin), c = (unsigned)fmaxf(fmaf(g[2], 255.f, 0.5f), qmin), d = (unsigned)fmaxf(fmaf(g[3], 255.f, 0.5f), qmin);
    return a | (b << 8) | (c << 16) | (d << 24);
}
__device__ __forceinline__ float ub0(unsigned w) { return (float)(w & 0xffu); }
__device__ __forceinline__ float ub1(unsigned w) { return (float)((w >> 8) & 0xffu); }
__device__ __forceinline__ float ub2(unsigned w) { return (float)((w >> 16) & 0xffu); }
__device__ __forceinline__ float ub3(unsigned w) { return (float)(w >> 24); }
struct EpiProj {
    static constexpr int MID_T = 0;
    bf16_t *QSB, *KSB, *VSB, *QSA, *KSA, *VSA, *QIX, *KIX, *G1, *G2; float* WIX;
    LAS const float* tab; int pm0; const float* RS; int pn_off; float gexp, ascale;
    __device__ __forceinline__ void init(Acc& acc, const Unit&, int, int, int, int) const {
#pragma unroll
        for (int a = 0; a < 2; ++a)
#pragma unroll
            for (int b = 0; b < 2; ++b)
#pragma unroll
                for (int m = 0; m < 4; ++m)
#pragma unroll
                    for (int n = 0; n < 2; ++n) acc[a][b][m][n] = (f32x4){0.f, 0.f, 0.f, 0.f};
    }
    __device__ __forceinline__ void mid(Acc&, const Unit&, int, int, int, int) const {}
    __device__ __forceinline__ void operator()(Acc& acc, const Unit& u, int wr, int wc, int fr, int fq) const {
        int row0_ = u.pm * BM + wr * 64 + fr, lc_ = 64 * wc + 8 * fq; asm volatile("" : "+v"(row0_), "+v"(lc_));
        const int pn = pn_off ? tile_b(u.pn) : tile_a(u.pn), row0 = row0_, lc = lc_;
        int mode = 4, ld = 0, dcol = 0, gain = 0; bf16_t* dst = nullptr; float gmin = 0.f;
        if (pn < 2)       { mode = 1; dst = QSB; ld = 512; dcol = pn * 256 + lc; gain = 256; }
        else if (pn < 4)  { mode = 1; dst = KSB; ld = 512; dcol = (pn - 2) * 256 + lc; gain = 320; }
        else if (pn < 6)  { mode = 0; dst = VSB; ld = 512; dcol = (pn - 4) * 256 + lc; }
        else if (pn < 8)  { mode = 1; dst = QSA; ld = 512; dcol = (pn - 6) * 256 + lc; gain = 384; }
        else if (pn == 8) { if (wc < 2) { mode = 1; dst = KSA; ld = 128; dcol = lc; gain = 448; } else { mode = 0; dst = VSA; ld = 128; dcol = lc - 128; } }
        else if (pn == 9) { mode = 0; dst = QIX; ld = 256; dcol = lc; }
        else if (pn == 10) { mode = (wc == 0) ? 3 : 4; }
        else if (pn < 15) { mode = 2; dst = G1; ld = 1024; dcol = (pn - 11) * 256 + lc; }
        else              { mode = 2; dst = G2; ld = 1024; dcol = (pn - 15) * 256 + lc; gmin = 1.f; }
        if (mode == 4) return;
        if (mode == 3) {
#pragma unroll
            for (int ai = 0; ai < 2; ++ai)
#pragma unroll
                for (int m = 0; m < 4; ++m) { const size_t row = (size_t)(row0 + ai * HALF + m * 16); const float r = RS ? (u.pm == pm0 ? tab[row & 255] : RS[row]) : 1.f;
                    *(u32x4*)(KIX + row * 32 + 8 * fq) = pack8(acc[ai][0][m][0] * r, acc[ai][0][m][1] * r);
                    if (fq == 0) { *(f32x4*)(WIX + row * 8) = acc[ai][1][m][0] * (0.0625f * r); *(f32x4*)(WIX + row * 8 + 4) = acc[ai][1][m][1] * (0.0625f * r); } }
            return;
        }
        f32x4 gv[2][2];
#pragma unroll
        for (int bj = 0; bj < 2; ++bj)
#pragma unroll
            for (int n = 0; n < 2; ++n) gv[bj][n] = (mode == 1) ? *(LAS const f32x4*)(tab + gain + 32 * bj + (lc & 63) + 4 * n) : (f32x4){1.f, 1.f, 1.f, 1.f};
#pragma unroll
        for (int ai = 0; ai < 2; ++ai)
#pragma unroll
            for (int m = 0; m < 4; ++m) { bf16_t* rowp = dst + (size_t)(row0 + ai * HALF + m * 16) * ld + dcol;
                f32x4 v[2][2]; const float rrow = (RS ? (u.pm == pm0 ? tab[(row0 + ai * HALF + m * 16) & 255] : RS[row0 + ai * HALF + m * 16]) : 1.f) * ascale;
#pragma unroll
                for (int bj = 0; bj < 2; ++bj)
#pragma unroll
                    for (int n = 0; n < 2; ++n) v[bj][n] = acc[ai][bj][m][n] * rrow;
                if (mode == 1) {
                    float ss = 0.f;
#pragma unroll
                    for (int bj = 0; bj < 2; ++bj)
#pragma unroll
                        for (int n = 0; n < 2; ++n) ss += (v[bj][n][0] * v[bj][n][0] + v[bj][n][1] * v[bj][n][1]) + (v[bj][n][2] * v[bj][n][2] + v[bj][n][3] * v[bj][n][3]);
                    ss += __shfl_xor(ss, 16); ss += __shfl_xor(ss, 32);
                    const float rs = __builtin_amdgcn_rsqf(ss * (1.f / 64.f) + EPS);
#pragma unroll
                    for (int bj = 0; bj < 2; ++bj)
#pragma unroll
                        for (int n = 0; n < 2; ++n) v[bj][n] = v[bj][n] * gv[bj][n] * rs;
                } else if (mode == 2) {
#pragma unroll
                    for (int bj = 0; bj < 2; ++bj)
#pragma unroll
                        for (int n = 0; n < 2; ++n)
#pragma unroll
                            for (int e = 0; e < 4; ++e) v[bj][n][e] = __builtin_amdgcn_rcpf(1.f + __builtin_amdgcn_exp2f(gexp * v[bj][n][e]));
                }
                if (mode == 2) {
                    unsigned char* rowb = (unsigned char*)dst + (size_t)(row0 + ai * HALF + m * 16) * 1024 + dcol;
#pragma unroll
                    for (int bj = 0; bj < 2; ++bj) { u32x2 w;
                        w.x = gate_u8x4(v[bj][0], gmin); w.y = gate_u8x4(v[bj][1], gmin);
                        *(u32x2*)(rowb + 32 * bj) = w; }
                } else {
#pragma unroll
                    for (int bj = 0; bj < 2; ++bj) *(u32x4*)(rowp + 32 * bj) = pack8(v[bj][0], v[bj][1]);
                }
            }
    }
};

struct EpiMerge {
    static constexpr int MID_T = 4;
    const unsigned char *G1, *G2; bf16_t* MG;
    __device__ __forceinline__ void init(Acc& acc, const Unit&, int, int, int, int) const {
#pragma unroll
        for (int a = 0; a < 2; ++a)
#pragma unroll
            for (int b = 0; b < 2; ++b)
#pragma unroll
                for (int m = 0; m < 4; ++m)
#pragma unroll
                    for (int n = 0; n < 2; ++n) acc[a][b][m][n] = (f32x4){0.f, 0.f, 0.f, 0.f};
    }
    __device__ __forceinline__ void mid(Acc& acc, const Unit& u, int wr, int wc, int fr, int fq) const {
        int row0 = u.pm * BM + wr * 64 + fr, col0 = u.pn * BM + 64 * wc + 8 * fq;
        asm volatile("" : "+v"(row0), "+v"(col0));
#pragma unroll
        for (int ai = 0; ai < 2; ++ai) {
            u32x2 ga[4][2], gb[4][2];
#pragma unroll
            for (int m = 0; m < 4; ++m) { const size_t off = (size_t)(row0 + ai * HALF + m * 16) * 1024 + col0;
#pragma unroll
                for (int bj = 0; bj < 2; ++bj) { ga[m][bj] = *(const u32x2*)(G1 + off + 32 * bj); gb[m][bj] = *(const u32x2*)(G2 + off + 32 * bj); } }
#pragma unroll
            for (int m = 0; m < 4; ++m)
#pragma unroll
                for (int bj = 0; bj < 2; ++bj) { const u32x2 a = ga[m][bj], b = gb[m][bj];
                    f32x4& c0 = acc[ai][bj][m][0]; f32x4& c1 = acc[ai][bj][m][1];
                    c0[0] *= ub0(a.x) * __builtin_amdgcn_rcpf(ub0(b.x)); c0[1] *= ub1(a.x) * __builtin_amdgcn_rcpf(ub1(b.x));
                    c0[2] *= ub2(a.x) * __builtin_amdgcn_rcpf(ub2(b.x)); c0[3] *= ub3(a.x) * __builtin_amdgcn_rcpf(ub3(b.x));
                    c1[0] *= ub0(a.y) * __builtin_amdgcn_rcpf(ub0(b.y)); c1[1] *= ub1(a.y) * __builtin_amdgcn_rcpf(ub1(b.y));
                    c1[2] *= ub2(a.y) * __builtin_amdgcn_rcpf(ub2(b.y)); c1[3] *= ub3(a.y) * __builtin_amdgcn_rcpf(ub3(b.y)); }
            asm volatile("" ::: "memory");
        }
    }
    __device__ __forceinline__ void operator()(Acc& acc, const Unit& u, int wr, int wc, int fr, int fq) const {
        const int row0 = u.pm * BM + wr * 64 + fr, col0 = u.pn * BM + 64 * wc + 8 * fq;
#pragma unroll
        for (int ai = 0; ai < 2; ++ai)
#pragma unroll
            for (int m = 0; m < 4; ++m) { const size_t off = (size_t)(row0 + ai * HALF + m * 16) * 1024 + col0;
#pragma unroll
                for (int bj = 0; bj < 2; ++bj) { const u32x2 gw = *(const u32x2*)(G2 + off + 32 * bj); const float b[8] = {ub0(gw.x), ub1(gw.x), ub2(gw.x), ub3(gw.x), ub0(gw.y), ub1(gw.y), ub2(gw.y), ub3(gw.y)};
                    f32x4 v0 = acc[ai][bj][m][0], v1 = acc[ai][bj][m][1];
#pragma unroll
                    for (int e = 0; e < 4; ++e) { v0[e] *= b[e] * (MG_SCALE / (255.f * O_SCALE * WCAT_SCALE)); v1[e] *= b[4 + e] * (MG_SCALE / (255.f * O_SCALE * WCAT_SCALE)); }
                    u32x2 w; w.x = pk4_fp8(v0[0], v0[1], v0[2], v0[3]); w.y = pk4_fp8(v1[0], v1[1], v1[2], v1[3]);
                    *(u32x2*)((unsigned char*)MG + off + 32 * bj) = w; } }
    }
};

struct EpiWout {
    static constexpr int MID_T = 0;
    bf16_t* X1B; float* SSQ; unsigned char* X18;
    __device__ __forceinline__ void init(Acc& acc, const Unit& u, int wr, int wc, int fr, int fq) const {
        const int row0 = u.pm * BM + wr * 64 + fr, col0 = u.pn * BM + 64 * wc + 8 * fq;
#pragma unroll
        for (int ai = 0; ai < 2; ++ai)
#pragma unroll
            for (int m = 0; m < 4; ++m) { const size_t off = (size_t)(row0 + ai * HALF + m * 16) * 1024 + col0;
#pragma unroll
                for (int bj = 0; bj < 2; ++bj) { float xb[8]; unpack8(*(const u32x4*)(X1B + off + 32 * bj), xb);
                    acc[ai][bj][m][0] = (f32x4){xb[0], xb[1], xb[2], xb[3]} * (MG_SCALE * WOUT_SCALE); acc[ai][bj][m][1] = (f32x4){xb[4], xb[5], xb[6], xb[7]} * (MG_SCALE * WOUT_SCALE); } }
    }
    __device__ __forceinline__ void mid(Acc&, const Unit&, int, int, int, int) const {}
    __device__ __forceinline__ void operator()(Acc& acc, const Unit& u, int wr, int wc, int fr, int fq) const {
        const int row0 = u.pm * BM + wr * 64 + fr, col0 = u.pn * BM + 64 * wc + 8 * fq;
#pragma unroll
        for (int ai = 0; ai < 2; ++ai)
#pragma unroll
            for (int m = 0; m < 4; ++m) { const int row = row0 + ai * HALF + m * 16; const size_t off = (size_t)row * 1024 + col0; float ss = 0.f;
#pragma unroll
                for (int bj = 0; bj < 2; ++bj) { f32x4 v[2];
#pragma unroll
                    for (int n = 0; n < 2; ++n) { v[n] = acc[ai][bj][m][n] * (1.f / (MG_SCALE * WOUT_SCALE));
                        ss += (v[n][0] * v[n][0] + v[n][1] * v[n][1]) + (v[n][2] * v[n][2] + v[n][3] * v[n][3]); }
                    *(u32x4*)(X1B + off + 32 * bj) = pack8(v[0], v[1]);
                    { u32x2 w8; w8.x = pk4_fp8(v[0][0] * X1_SCALE, v[0][1] * X1_SCALE, v[0][2] * X1_SCALE, v[0][3] * X1_SCALE); w8.y = pk4_fp8(v[1][0] * X1_SCALE, v[1][1] * X1_SCALE, v[1][2] * X1_SCALE, v[1][3] * X1_SCALE); *(u32x2*)(X18 + off + 32 * bj) = w8; } }
                ss += __shfl_xor(ss, 16); ss += __shfl_xor(ss, 32);
                if (fq == 0) SSQ[(size_t)row * 16 + u.pn * 4 + wc] = ss;
                if (m & 1) asm volatile("" ::: "memory"); }
    }
};

struct EpiUp {
    static constexpr int MID_T = 0;
    const float* SSQ; bf16_t* U; LAS const float* r2tab; int pm0;
    __device__ __forceinline__ void init(Acc& acc, const Unit&, int, int, int, int) const {
#pragma unroll
        for (int a = 0; a < 2; ++a)
#pragma unroll
            for (int b = 0; b < 2; ++b)
#pragma unroll
                for (int m = 0; m < 4; ++m)
#pragma unroll
                    for (int n = 0; n < 2; ++n) acc[a][b][m][n] = (f32x4){0.f, 0.f, 0.f, 0.f};
    }
    __device__ __forceinline__ void mid(Acc&, const Unit&, int, int, int, int) const {}
    __device__ __forceinline__ void operator()(Acc& acc, const Unit& u, int wr, int wc, int fr, int fq) const {
        const int row0 = u.pm * BM + wr * 64 + fr, col0 = u.pn * BM + 64 * wc + 8 * fq;
#pragma unroll
        for (int ai = 0; ai < 2; ++ai)
#pragma unroll
            for (int m = 0; m < 4; ++m) { const int row = row0 + ai * HALF + m * 16; float r2;
                if (u.pm == pm0) r2 = r2tab[row & 255];
                else { const f32x4* sp = (const f32x4*)(SSQ + (size_t)row * 16);
                    const f32x4 s0 = sp[0], s1 = sp[1], s2 = sp[2], s3 = sp[3]; const f32x4 st = (s0 + s1) + (s2 + s3);
                    r2 = __builtin_amdgcn_rcpf(((st[0] + st[1]) + (st[2] + st[3])) * (1.f / 1024.f) + EPS) * (1.f / ((X1_SCALE * W1_SCALE) * (X1_SCALE * W1_SCALE))); }
#pragma unroll
                for (int bj = 0; bj < 2; ++bj) { f32x4 v[2];
#pragma unroll
                    for (int n = 0; n < 2; ++n)
#pragma unroll
                        for (int e = 0; e < 4; ++e) { const float a = fmaxf(acc[ai][bj][m][n][e], 0.f); v[n][e] = a * a * (r2 * U_SCALE); }
                    u32x2 w; w.x = pk4_fp8(v[0][0], v[0][1], v[0][2], v[0][3]); w.y = pk4_fp8(v[1][0], v[1][1], v[1][2], v[1][3]);
                    *(u32x2*)((unsigned char*)U + (size_t)row * FF + col0 + 32 * bj) = w; } }
    }
};

struct EpiDown {
    static constexpr int MID_T = 0;
    const bf16_t* X1B; float* OUT;
    __device__ __forceinline__ void init(Acc& acc, const Unit& u, int wr, int wc, int fr, int fq) const {
        const int row0 = u.pm * BM + wr * 64 + fr, col0 = u.pn * BM + 64 * wc + 8 * fq;
#pragma unroll
        for (int ai = 0; ai < 2; ++ai)
#pragma unroll
            for (int m = 0; m < 4; ++m) { const size_t off = (size_t)(row0 + ai * HALF + m * 16) * 1024 + col0;
#pragma unroll
                for (int bj = 0; bj < 2; ++bj) { float xb[8]; unpack8(*(const u32x4*)(X1B + off + 32 * bj), xb);
                    acc[ai][bj][m][0] = (f32x4){xb[0], xb[1], xb[2], xb[3]} * (U_SCALE * W2_SCALE); acc[ai][bj][m][1] = (f32x4){xb[4], xb[5], xb[6], xb[7]} * (U_SCALE * W2_SCALE); } }
    }
    __device__ __forceinline__ void mid(Acc&, const Unit&, int, int, int, int) const {}
    __device__ __forceinline__ void operator()(Acc& acc, const Unit& u, int wr, int wc, int fr, int fq) const {
        const int row0 = u.pm * BM + wr * 64 + fr, col0 = u.pn * BM + 64 * wc + 8 * fq;
#pragma unroll
        for (int ai = 0; ai < 2; ++ai)
#pragma unroll
            for (int m = 0; m < 4; ++m) { const size_t off = (size_t)(row0 + ai * HALF + m * 16) * 1024 + col0;
#pragma unroll
                for (int bj = 0; bj < 2; ++bj) { *(f32x4*)(OUT + off + 32 * bj) = acc[ai][bj][m][0] * (1.f / (U_SCALE * W2_SCALE)); *(f32x4*)(OUT + off + 32 * bj + 4) = acc[ai][bj][m][1] * (1.f / (U_SCALE * W2_SCALE)); }
                if (m & 1) asm volatile("" ::: "memory"); }
    }
};
}

namespace idx {
template <int CTRL> __device__ __forceinline__ unsigned dppmov(unsigned x) { return (unsigned)__builtin_amdgcn_update_dpp(0, (int)x, CTRL, 0xf, 0xf, false); }
__device__ __forceinline__ unsigned half_sum(unsigned x, int hi) {
    x += dppmov<0x128>(x); x += dppmov<0x124>(x); x += dppmov<0x122>(x); x += dppmov<0x121>(x);
    const unsigned lo = (unsigned)__builtin_amdgcn_readlane((int)x, 0) + (unsigned)__builtin_amdgcn_readlane((int)x, 16);
    const unsigned up = (unsigned)__builtin_amdgcn_readlane((int)x, 32) + (unsigned)__builtin_amdgcn_readlane((int)x, 48);
    return hi ? up : lo;
}
typedef unsigned short u16x2 __attribute__((ext_vector_type(2)));
__device__ __forceinline__ unsigned wlane(unsigned v, unsigned sval, int lane) { asm volatile("s_nop 1\n\tv_writelane_b32 %0, %1, %2" : "+v"(v) : "s"(sval), "n"(lane)); return v; }
template <bool MAX> __device__ __forceinline__ float half_minmax(float x, int hi) {
#define MM(a, b) (MAX ? fmaxf((a), (b)) : fminf((a), (b)))
    x = MM(x, __uint_as_float(dppmov<0x128>(__float_as_uint(x)))); x = MM(x, __uint_as_float(dppmov<0x124>(__float_as_uint(x))));
    x = MM(x, __uint_as_float(dppmov<0x122>(__float_as_uint(x)))); x = MM(x, __uint_as_float(dppmov<0x121>(__float_as_uint(x))));
    const float lo = MM(__uint_as_float((unsigned)__builtin_amdgcn_readlane((int)__float_as_uint(x), 0)), __uint_as_float((unsigned)__builtin_amdgcn_readlane((int)__float_as_uint(x), 16)));
    const float up = MM(__uint_as_float((unsigned)__builtin_amdgcn_readlane((int)__float_as_uint(x), 32)), __uint_as_float((unsigned)__builtin_amdgcn_readlane((int)__float_as_uint(x), 48)));
#undef MM
    return hi ? up : lo;
}
__device__ __forceinline__ void idx_unit(int b, int qblk, const bf16_t* __restrict__ QIX, const bf16_t* __restrict__ KIX, const float* __restrict__ WIX, unsigned* __restrict__ MASK, LAS char* wlds) {
    int tid_ = threadIdx.x; asm volatile("" : "+v"(tid_));
    const int tid = tid_, lane = tid & 63, r32 = lane & 31, hi = lane >> 5; const int wid = __builtin_amdgcn_readfirstlane(tid >> 6);
    const size_t rowbase = (size_t)b * SEQ; const int tbase = qblk * 32 + wid * 4;
    const int ri = r32, rhi = (ri >> 2) & 1, blk = ri >> 3, qoff = (rhi ? 2 : 0) + (blk >> 1), head = (blk & 1) * 4 + (ri & 3);
    bf16x8 af[2];
#pragma unroll
    for (int ks = 0; ks < 2; ++ks) af[ks] = *(const bf16x8*)(QIX + (rowbase + tbase + qoff) * 256 + head * 32 + ks * 16 + hi * 8);
    const int qA = tbase + (hi ? 2 : 0), qB = qA + 1;
    float wA[8], wB[8];
    { const f32x4 a0 = *(const f32x4*)(WIX + (rowbase + qA) * 8), a1 = *(const f32x4*)(WIX + (rowbase + qA) * 8 + 4), b0 = *(const f32x4*)(WIX + (rowbase + qB) * 8), b1 = *(const f32x4*)(WIX + (rowbase + qB) * 8 + 4);
#pragma unroll
      for (int e = 0; e < 4; ++e) { wA[e] = a0[e]; wA[4 + e] = a1[e]; wB[e] = b0[e]; wB[4 + e] = b1[e]; } }
    const int jmax = qblk;
    { const GAS bf16_t* kp = (const GAS bf16_t*)(KIX + (rowbase + r32) * 32 + hi * 8);
      bf16x8 c0[4], c1[4], n0[4], n1[4];
#pragma unroll
      for (int u = 0; u < 4; ++u) { c0[u] = *(const GAS bf16x8*)(kp + (size_t)u * 1024); c1[u] = *(const GAS bf16x8*)(kp + (size_t)u * 1024 + 16); }
      LAS char* wp = wlds + lane * 4;
#pragma unroll 1
      for (int j0 = 0; j0 <= jmax; j0 += 4) {
          const int jn = (j0 + 4 <= 60) ? j0 + 4 : 60;
#pragma unroll
          for (int u = 0; u < 4; ++u) { n0[u] = *(const GAS bf16x8*)(kp + (size_t)(jn + u) * 1024); n1[u] = *(const GAS bf16x8*)(kp + (size_t)(jn + u) * 1024 + 16); }
          f32x16 cc[4];
#pragma unroll
          for (int u = 0; u < 4; ++u) { cc[u] = f32x16{}; cc[u] = __builtin_amdgcn_mfma_f32_32x32x16_bf16(af[0], c0[u], cc[u], 0, 0, 0); }
#pragma unroll
          for (int u = 0; u < 4; ++u) cc[u] = __builtin_amdgcn_mfma_f32_32x32x16_bf16(af[1], c1[u], cc[u], 0, 0, 0);
          float sa_[4], sb_[4];
#pragma unroll
          for (int u = 0; u < 4; ++u) {
              float a0 = 0.f, a1 = 0.f, b0 = 0.f, b1 = 0.f;
#pragma unroll
              for (int r = 0; r < 4; ++r) { a0 = fmaf(wA[r], fmaxf(cc[u][r], 0.f), a0); a1 = fmaf(wA[4 + r], fmaxf(cc[u][4 + r], 0.f), a1); b0 = fmaf(wB[r], fmaxf(cc[u][8 + r], 0.f), b0); b1 = fmaf(wB[4 + r], fmaxf(cc[u][12 + r], 0.f), b1); }
              sa_[u] = a0 + a1; sb_[u] = b0 + b1;
          }
          { typedef _Float16 h2_t __attribute__((ext_vector_type(2))); typedef float f2_t __attribute__((ext_vector_type(2)));
#pragma unroll
            for (int u = 0; u < 4; u += 2) { const int jj = (j0 + u) >> 1;
                *(LAS h2_t*)(wp + jj * 256) = __builtin_convertvector((f2_t){sa_[u], sa_[u + 1]}, h2_t);
                *(LAS h2_t*)(wp + 8192 + jj * 256) = __builtin_convertvector((f2_t){sb_[u], sb_[u + 1]}, h2_t); } }
#pragma unroll
          for (int u = 0; u < 4; ++u) { c0[u] = n0[u]; c1[u] = n1[u]; }
      } }
    const int nch = (jmax >> 3) + 1;
    unsigned pA[32], pB[32];
    asm volatile("s_waitcnt lgkmcnt(0)" ::: "memory");
#pragma unroll
    for (int ch = 0; ch < 8; ++ch) {
#pragma unroll
        for (int u = 0; u < 4; ++u) { pA[ch * 4 + u] = 0u; pB[ch * 4 + u] = 0u; }
        if (ch < nch) {
#pragma unroll
            for (int u = 0; u < 4; ++u) { const int jj = ch * 4 + u;
                typedef short s16x2_t __attribute__((ext_vector_type(2)));
                const unsigned ra = *(LAS const unsigned*)(wlds + lane * 4 + jj * 256), rb = *(LAS const unsigned*)(wlds + 8192 + lane * 4 + jj * 256);
                unsigned ka = ra ^ (__builtin_bit_cast(unsigned, __builtin_bit_cast(s16x2_t, ra) >> (short)15) | 0x80008000u), kb = rb ^ (__builtin_bit_cast(unsigned, __builtin_bit_cast(s16x2_t, rb) >> (short)15) | 0x80008000u);
                if (64 * jj + 63 > tbase) {
                    const int s0 = 64 * jj + r32, s1 = s0 + 32;
                    if (s0 > qA) ka &= 0xffff0000u; if (s1 > qA) ka &= 0x0000ffffu; if (s0 > qB) kb &= 0xffff0000u; if (s1 > qB) kb &= 0x0000ffffu; }
                pA[jj] = ka; pB[jj] = kb; }
        }
    }
    const unsigned nel = (unsigned)nch * 8u * 32u;
    auto count_lt = [&](unsigned cA, unsigned cB) -> unsigned {
        const unsigned c2A = cA | (cA << 16), c2B = cB | (cB << 16), one2 = 0x00010001u;
        u16x2 acA[4], acB[4];
#pragma unroll
        for (int u = 0; u < 4; ++u) { acA[u] = (u16x2){0, 0}; acB[u] = (u16x2){0, 0}; }
#pragma unroll
        for (int ch = 0; ch < 8; ++ch) {
            if (ch < nch) {
#pragma unroll
                for (int u = 0; u < 4; ++u) { const int jj = ch * 4 + u;
                    unsigned dA, dB, oA, oB;
                    asm("v_pk_sub_u16 %0, %1, %2 clamp" : "=v"(dA) : "v"(c2A), "v"(pA[jj])); asm("v_pk_sub_u16 %0, %1, %2 clamp" : "=v"(dB) : "v"(c2B), "v"(pB[jj]));
                    asm("v_pk_min_u16 %0, %1, %2" : "=v"(oA) : "v"(dA), "v"(one2)); asm("v_pk_min_u16 %0, %1, %2" : "=v"(oB) : "v"(dB), "v"(one2));
                    acA[u] += __builtin_bit_cast(u16x2, oA); acB[u] += __builtin_bit_cast(u16x2, oB); }
            }
        }
        const u16x2 accA = (acA[0] + acA[1]) + (acA[2] + acA[3]), accB = (acB[0] + acB[1]) + (acB[2] + acB[3]);
        const unsigned a = __builtin_bit_cast(unsigned, accA), bq = __builtin_bit_cast(unsigned, accB);
        return half_sum(((a & 0xffffu) + (a >> 16)) | (((bq & 0xffffu) + (bq >> 16)) << 16), hi);
    };
    unsigned TA = 0u, TB = 0u, geTA = 256u, geTB = 256u;
    if (tbase + 3 >= 256) {
#pragma unroll 1
        for (int bit = 15; bit >= 0; --bit) {
            const unsigned cA = TA | (1u << bit), cB = TB | (1u << bit);
            const unsigned lt = count_lt(cA, cB);
            const unsigned geA = nel - (lt & 0xffffu), geB = nel - (lt >> 16);
            if (geA >= 256u) { TA = cA; geTA = geA; }
            if (geB >= 256u) { TB = cB; geTB = geB; }
        }
    }
    if (qA + 1 <= 256) TA = 1u;
    if (qB + 1 <= 256) TB = 1u;
    int exA, exB;
    exA = (int)geTA - 256; exB = (int)geTB - 256; if (qA + 1 <= 256) exA = 0; if (qB + 1 <= 256) exB = 0;
    unsigned m0 = 0u, m1 = 0u, m2 = 0u, m3 = 0u;
    const bool anyt = __any((exA > 0) || (exB > 0));
    unsigned t0 = 0u, t1 = 0u, t2 = 0u, t3 = 0u;
#pragma unroll
    for (int ch = 0; ch < 8; ++ch) {
        if (ch < nch) {
#pragma unroll
            for (int u = 0; u < 8; ++u) { const int j = ch * 8 + u;
                const unsigned eA = (j & 1) ? (pA[j >> 1] >> 16) : (pA[j >> 1] & 0xffffu), eB = (j & 1) ? (pB[j >> 1] >> 16) : (pB[j >> 1] & 0xffffu);
                const unsigned long long gA = __ballot(eA >= TA), gB = __ballot(eB >= TB);
                m0 = wlane(m0, (unsigned)gA, j); m2 = wlane(m2, (unsigned)(gA >> 32), j); m1 = wlane(m1, (unsigned)gB, j); m3 = wlane(m3, (unsigned)(gB >> 32), j);
                if (anyt) { const unsigned long long qA_ = __ballot(eA == TA), qB_ = __ballot(eB == TB);
                    t0 = wlane(t0, (unsigned)qA_, j); t2 = wlane(t2, (unsigned)(qA_ >> 32), j); t1 = wlane(t1, (unsigned)qB_, j); t3 = wlane(t3, (unsigned)(qB_ >> 32), j); } }
        }
    }
    if (anyt) {
#define IDX_DROP(mq, tq, exq) { int ex_ = (exq); \
            while (ex_ > 0) { const unsigned long long nz_ = __ballot(tq != 0u); if (nz_ == 0ull) break; \
                const int jt_ = 63 - __builtin_clzll(nz_); const unsigned w_ = (unsigned)__builtin_amdgcn_readlane((int)tq, jt_); const unsigned top_ = 0x80000000u >> __builtin_clz(w_); \
                if (lane == jt_) { tq &= ~top_; mq &= ~top_; } --ex_; } }
        const int e0 = __builtin_amdgcn_readlane(exA, 0), e2 = __builtin_amdgcn_readlane(exA, 32), e1 = __builtin_amdgcn_readlane(exB, 0), e3 = __builtin_amdgcn_readlane(exB, 32);
        IDX_DROP(m0, t0, e0) IDX_DROP(m1, t1, e1) IDX_DROP(m2, t2, e2) IDX_DROP(m3, t3, e3)
#undef IDX_DROP
    }
    unsigned* mp = MASK + (rowbase + tbase) * 64 + lane;
    asm volatile("global_store_dword %0, %1, off sc1\n\tglobal_store_dword %0, %2, off offset:256 sc1\n\tglobal_store_dword %0, %3, off offset:512 sc1\n\tglobal_store_dword %0, %4, off offset:768 sc1\n\ts_nop 1\n\ts_waitcnt vmcnt(0)"
                 :: "v"(mp), "v"(m0), "v"(m1), "v"(m2), "v"(m3) : "memory");
}
}

namespace att {
typedef float f32x2 __attribute__((ext_vector_type(2)));
typedef LAS const char* lds_cptr;
__device__ __forceinline__ int crow(int r, int hi) { return (r & 3) + 8 * (r >> 2) + 4 * hi; }
__device__ __forceinline__ s16x4 vtr(lds_cptr p) { return __builtin_bit_cast(s16x4, __builtin_amdgcn_ds_read_tr16_b64_v4i16((LAS v4i16_t*)p)); }
constexpr int KVBUF = 16384;
constexpr int LDS_KV = 0, LDS_OST = 2 * KVBUF, LDS_WS = LDS_OST + 8 * 4096, LDS_MASK = LDS_WS + 8 * 256, MASK_STRIDE = 66, LDS_ATT_BYTES = LDS_MASK + 64 * MASK_STRIDE * 4;

struct TileLd { u32x4 k, v; };
__device__ __forceinline__ void tile_load(TileLd& t, const bf16_t* Kh, const bf16_t* Vh, int pitch, int key0, int wid, int lane) {
    t.k = *(const u32x4*)(Kh + (size_t)(key0 + lane) * pitch + wid * 8);
    t.v = *(const u32x4*)(Vh + (size_t)(key0 + 16 * (wid & 3) + (lane >> 2)) * pitch + (wid >> 2) * 32 + (lane & 3) * 8);
}
__device__ __forceinline__ void tile_store(const TileLd& t, LAS char* buf, int wid, int lane) {
    *(LAS u32x4*)(buf + wid * 1024 + lane * 16) = t.k;
    *(LAS u32x4*)(buf + 8192 + wid * 1024 + lane * 16) = t.v;
}
#define ATT_SBAR() __builtin_amdgcn_sched_barrier(0)
__device__ __forceinline__ void kload8(bf16x8 (&kf)[8], lds_cptr Kb, int r32, int hi) {
    lds_cptr kp = Kb + hi * 1024 + r32 * 16;
#pragma unroll
    for (int d0 = 0; d0 < 4; ++d0) { kf[2 * d0] = *(LAS const bf16x8*)(kp + d0 * 2048); kf[2 * d0 + 1] = *(LAS const bf16x8*)(kp + d0 * 2048 + 512); }
}
__device__ __forceinline__ void qkt_r(f32x16& p0, f32x16& p1, const bf16x8 (&kf)[8], const bf16x8* qr) {
#pragma unroll
    for (int d0 = 0; d0 < 4; ++d0) {
        p0 = __builtin_amdgcn_mfma_f32_32x32x16_bf16(kf[2 * d0], qr[d0], p0, 0, 0, 0);
        p1 = __builtin_amdgcn_mfma_f32_32x32x16_bf16(kf[2 * d0 + 1], qr[d0], p1, 0, 0, 0);
    }
}
__device__ __forceinline__ void vload16(s16x4 (&vl)[8], s16x4 (&vu)[8], lds_cptr Vb, int lane, int hi) {
    lds_cptr vp = Vb + ((lane >> 4) & 1) * 32 + (lane & 3) * 8 + (4 * hi + ((lane & 15) >> 2)) * 64;
#pragma unroll
    for (int d0 = 0; d0 < 2; ++d0)
#pragma unroll
        for (int ks = 0; ks < 4; ++ks) { vl[d0 * 4 + ks] = vtr(vp + d0 * 4096 + ks * 1024); vu[d0 * 4 + ks] = vtr(vp + d0 * 4096 + ks * 1024 + 512); }
}
__device__ __forceinline__ void pv_r(f32x16* o, const s16x4 (&vl)[8], const s16x4 (&vu)[8], const u32x4 (&pw)[4]) {
#pragma unroll
    for (int ks = 0; ks < 4; ++ks)
#pragma unroll
        for (int d0 = 0; d0 < 2; ++d0) { const s16x4 lo = vl[d0 * 4 + ks], up = vu[d0 * 4 + ks];
            const bf16x8 vf = (bf16x8){lo[0], lo[1], lo[2], lo[3], up[0], up[1], up[2], up[3]};
            o[d0] = __builtin_amdgcn_mfma_f32_32x32x16_bf16(__builtin_bit_cast(bf16x8, pw[ks]), vf, o[d0], 0, 0, 0); }
}
__device__ __forceinline__ void pack_p(u32x4 (&pw)[4], const f32x16& p0, const f32x16& p1) {
    pw[0] = (u32x4){cvtpk(p0[0], p0[1]), cvtpk(p0[2], p0[3]), cvtpk(p0[4], p0[5]), cvtpk(p0[6], p0[7])};
    pw[1] = (u32x4){cvtpk(p0[8], p0[9]), cvtpk(p0[10], p0[11]), cvtpk(p0[12], p0[13]), cvtpk(p0[14], p0[15])};
    pw[2] = (u32x4){cvtpk(p1[0], p1[1]), cvtpk(p1[2], p1[3]), cvtpk(p1[4], p1[5]), cvtpk(p1[6], p1[7])};
    pw[3] = (u32x4){cvtpk(p1[8], p1[9]), cvtpk(p1[10], p1[11]), cvtpk(p1[12], p1[13]), cvtpk(p1[14], p1[15])};
}
__device__ __forceinline__ void store_o(const f32x16* o, bf16_t* Ow_, int opitch, LAS char* stg, int lane, int r32, int hi) {
    unsigned char* Ow = (unsigned char*)Ow_;
    LAS unsigned char* s = (LAS unsigned char*)stg;
#pragma unroll
    for (int r = 0; r < 16; ++r) { const int orow = crow(r, hi);
        const unsigned pk = pk4_fp8(o[0][r] * O_SCALE, o[1][r] * O_SCALE, 0.f, 0.f);
        s[orow * 64 + r32] = (unsigned char)(pk & 0xffu); s[orow * 64 + 32 + r32] = (unsigned char)((pk >> 8) & 0xffu); }
    asm volatile("s_waitcnt lgkmcnt(0)" ::: "memory");
    { const int row = lane >> 1, hf = lane & 1; const u32x4 v0 = *(LAS const u32x4*)(s + row * 64 + hf * 32), v1 = *(LAS const u32x4*)(s + row * 64 + hf * 32 + 16);
      *(u32x4*)(Ow + (size_t)row * opitch + hf * 32) = v0; *(u32x4*)(Ow + (size_t)row * opitch + hf * 32 + 16) = v1; }
    asm volatile("s_waitcnt lgkmcnt(0)" ::: "memory");
}

__device__ __forceinline__ bool carry_done(float carry) { return __all(carry < 9.0949470177e-13f); }
__device__ __forceinline__ void sb_tile(LAS char* buf, int jb, const bf16x8* qr, f32x16* o, float& carry, LAS unsigned* dfl, int wid, int wq, int lane, int r32, int hi, int qrel) {
    const bool skip = (jb >= 0) && (64 * jb >= 32 * wq + 31);
    if (skip || carry_done(carry)) return;
    f32x16 p0 = f32x16{}, p1 = f32x16{};
    bf16x8 kf[8]; kload8(kf, (lds_cptr)buf, r32, hi); ATT_SBAR();
    qkt_r(p0, p1, kf, qr);
    s16x4 vl[8], vu[8]; vload16(vl, vu, (lds_cptr)buf + 8192, lane, hi); ATT_SBAR();
#pragma unroll
    for (int r = 0; r < 16; ++r) { p0[r] = __builtin_amdgcn_exp2f(p0[r]); p1[r] = __builtin_amdgcn_exp2f(p1[r]); }
    if (jb >= 0 && 64 * jb + 63 >= 32 * wq) {
#pragma unroll
        for (int r = 0; r < 16; ++r) { const int kv = 64 * jb + crow(r, hi); if (kv >= qrel) p0[r] = 0.f; if (kv + 32 >= qrel) p1[r] = 0.f; }
    }
    f32x16 r0, r1;
#pragma unroll
    for (int r = 0; r < 16; ++r) { r0[r] = __builtin_amdgcn_rcpf(1.f + p0[r]); r1[r] = __builtin_amdgcn_rcpf(1.f + p1[r]); }
    float pp[8], part[8];
#pragma unroll
    for (int a = 0; a < 8; ++a) {
        const float g = (a < 4) ? (r0[4 * a] * r0[4 * a + 1]) * (r0[4 * a + 2] * r0[4 * a + 3]) : (r1[4 * a - 16] * r1[4 * a - 15]) * (r1[4 * a - 14] * r1[4 * a - 13]);
        const auto rr = __builtin_amdgcn_permlane32_swap(__float_as_uint(g), __float_as_uint(g), false, false);
        const float x0 = __uint_as_float(rr[0]), x1 = __uint_as_float(rr[1]);
        pp[a] = x0 * x1;
        part[a] = hi ? 1.f : x1;
    }
    float sp = carry;
#pragma unroll
    for (int a = 7; a >= 0; --a) {
        const float E = sp * part[a];
        if (a < 4) { const float R3 = E * r0[4 * a + 3], R2 = R3 * r0[4 * a + 2], R1 = R2 * r0[4 * a + 1], R0 = R1 * r0[4 * a];
            p0[4 * a + 3] *= R3; p0[4 * a + 2] *= R2; p0[4 * a + 1] *= R1; p0[4 * a] *= R0; }
        else { const int c = 4 * a - 16; const float R3 = E * r1[c + 3], R2 = R3 * r1[c + 2], R1 = R2 * r1[c + 1], R0 = R1 * r1[c];
            p1[c + 3] *= R3; p1[c + 2] *= R2; p1[c + 1] *= R1; p1[c] *= R0; }
        sp *= pp[a];
    }
    carry = sp;
    u32x4 pw[4]; pack_p(pw, p0, p1);
    ATT_SBAR(); pv_r(o, vl, vu, pw);
    const bool done = carry_done(carry);
    if (lane == 0) dfl[wid] = done ? 1u : 0u;
}

constexpr int SBM_BUF = 2 * KVBUF, SBM_OST = 2 * SBM_BUF, SBM_WS = SBM_OST + 8 * 4096;
__device__ __forceinline__ void sb_unit(int b, int hp, int R, const bf16_t* __restrict__ Q, const bf16_t* __restrict__ K, const bf16_t* __restrict__ V, bf16_t* __restrict__ OC, LAS char* shm) {
    int tid_ = threadIdx.x; asm volatile("" : "+v"(tid_));
    const int tid = tid_, lane = tid & 63, r32 = lane & 31, hi = lane >> 5; const int wid = __builtin_amdgcn_readfirstlane(tid >> 6);
    const int hh = (wid >> 1) & 1, wq = (wid & 1) + 2 * (wid >> 2), h = 2 * hp + hh;
    const size_t rowbase = (size_t)b * SEQ; const int q0 = R * 128;
    const bf16_t* Qw = Q + (rowbase + q0 + wq * 32) * 512 + h * 64;
    const bf16_t* Kh = K + rowbase * 512 + (2 * hp) * 64; const bf16_t* Vh = V + rowbase * 512 + (2 * hp) * 64;
    bf16x8 qr[4];
#pragma unroll
    for (int d0 = 0; d0 < 4; ++d0) qr[d0] = *(const bf16x8*)(Qw + (size_t)r32 * 512 + d0 * 16 + hi * 8);
    const int NT = 2 * (R + 1);
    f32x16 o[2]; o[0] = f32x16{}; o[1] = f32x16{};
    float carry = 1.f;
    const int qrel = wq * 32 + r32;
    TileLd tA0, tA1, tB0, tB1;
    tile_load(tA0, Kh, Vh, 512, (NT - 1) * 64, wid, lane); tile_load(tA1, Kh + 64, Vh + 64, 512, (NT - 1) * 64, wid, lane);
    tile_store(tA0, shm, wid, lane); tile_store(tA1, shm + KVBUF, wid, lane);
    tile_load(tA0, Kh, Vh, 512, (NT - 2) * 64, wid, lane); tile_load(tA1, Kh + 64, Vh + 64, 512, (NT - 2) * 64, wid, lane);
    LAS unsigned* dfl = (LAS unsigned*)(shm + SBM_WS);
    if (lane == 0) dfl[wid] = 0u;
#define SB_STEP(I, ST0, ST1, LD0, LD1) { const int i = (I); const int jt = NT - 1 - i; \
        __syncthreads(); \
        { const u32x4 fa = *(LAS const u32x4*)dfl, fb = *(LAS const u32x4*)(dfl + 4); if ((fa.x & fa.y & fa.z & fa.w & fb.x & fb.y & fb.z & fb.w) != 0u) break; } \
        if (i + 2 < NT) { tile_load(LD0, Kh, Vh, 512, (jt - 2) * 64, wid, lane); tile_load(LD1, Kh + 64, Vh + 64, 512, (jt - 2) * 64, wid, lane); } \
        sb_tile(shm + (i & 1) * SBM_BUF + hh * KVBUF, jt - 2 * R, qr, o, carry, dfl, wid, wq, lane, r32, hi, qrel); \
        if (i + 1 < NT) { tile_store(ST0, shm + ((i + 1) & 1) * SBM_BUF, wid, lane); tile_store(ST1, shm + ((i + 1) & 1) * SBM_BUF + KVBUF, wid, lane); } }
    for (int i2 = 0; i2 < NT; i2 += 2) {
        SB_STEP(i2, tA0, tA1, tB0, tB1)
        if (i2 + 1 < NT) SB_STEP(i2 + 1, tB0, tB1, tA0, tA1)
    }
#undef SB_STEP
    store_o(o, (bf16_t*)((unsigned char*)OC + (rowbase + q0 + wq * 32) * 1024 + h * 64), 1024, shm + SBM_OST + wid * 4096, lane, r32, hi);
    __syncthreads();
}

__device__ __forceinline__ void sa_unit(int b, int g, int qb, const bf16_t* __restrict__ Q, const bf16_t* __restrict__ K, const bf16_t* __restrict__ V, const unsigned* __restrict__ MASK,
                                        bf16_t* __restrict__ OC, LAS char* shm) {
    const int tid = threadIdx.x, lane = tid & 63, r32 = lane & 31, hi = lane >> 5; const int wid = __builtin_amdgcn_readfirstlane(tid >> 6);
    const size_t rowbase = (size_t)b * SEQ; const int t0 = qb * 64, h = 4 * g + (wid >> 1), qloc = 32 * (wid & 1) + r32, t = t0 + qloc;
    const bf16_t* Qw = Q + (rowbase + t0 + 32 * (wid & 1)) * 512 + h * 64;
    const bf16_t* Kh = K + rowbase * 128 + g * 64; const bf16_t* Vh = V + rowbase * 128 + g * 64;
    bf16x8 qr[4];
#pragma unroll
    for (int d0 = 0; d0 < 4; ++d0) qr[d0] = *(const bf16x8*)(Qw + (size_t)r32 * 512 + d0 * 16 + hi * 8);
    LAS unsigned* mk = (LAS unsigned*)(shm + LDS_MASK);
#pragma unroll
    for (int i = 0; i < 8; ++i) { const int e = tid + i * 512, q = e >> 6, w = e & 63; mk[q * MASK_STRIDE + w] = MASK[(rowbase + t0 + q) * 64 + w]; }
    LAS float* wsf = (LAS float*)(shm + LDS_WS + wid * 256);
    const int NT = qb + 1;
    const float slope2 = __builtin_amdgcn_exp2f(-(float)(h + 1)) * 1.4426950408889634f;
    f32x16 o[2]; o[0] = f32x16{}; o[1] = f32x16{};
    float mrun = -1600.f, lsum = 0.f;
    TileLd tlA, tlB; tile_load(tlA, Kh, Vh, 128, (NT - 1) * 64, wid, lane);
    tile_store(tlA, shm + LDS_KV, wid, lane);
    if (NT > 1) tile_load(tlA, Kh, Vh, 128, (NT - 2) * 64, wid, lane);
    auto step = [&](const int i, TileLd& tst, TileLd& tld) {
        const int jt = NT - 1 - i;
        __syncthreads();
        if (i + 2 < NT) tile_load(tld, Kh, Vh, 128, (jt - 2) * 64, wid, lane);
        LAS char* buf = shm + LDS_KV + (i & 1) * KVBUF;
        bf16x8 kf[8]; kload8(kf, (lds_cptr)buf, r32, hi);
        const u32x2 mw = *(LAS const u32x2*)(mk + qloc * MASK_STRIDE + 2 * jt);
        ATT_SBAR();
        const unsigned w0 = mw.x >> (4 * hi), w1 = mw.y >> (4 * hi);
        const float base = slope2 * (float)(64 * jt + 4 * hi - t) - mrun;
        f32x16 p0, p1;
#pragma unroll
        for (int r = 0; r < 16; ++r) { const int cb = (r & 3) + 8 * (r >> 2); p0[r] = fmaf(slope2, (float)cb, base); p1[r] = fmaf(slope2, (float)(cb + 32), base); }
        qkt_r(p0, p1, kf, qr);
        s16x4 vl[8], vu[8]; vload16(vl, vu, (lds_cptr)buf + 8192, lane, hi); ATT_SBAR();
#pragma unroll
        for (int r = 0; r < 16; ++r) { const int cb = (r & 3) + 8 * (r >> 2);
            const unsigned m0 = (unsigned)__builtin_amdgcn_sbfe((int)w0, cb, 1), m1 = (unsigned)__builtin_amdgcn_sbfe((int)w1, cb, 1);
            p0[r] = __uint_as_float((__float_as_uint(p0[r]) & m0) | (0xf149f2cau & ~m0)); p1[r] = __uint_as_float((__float_as_uint(p1[r]) & m1) | (0xf149f2cau & ~m1)); }
        float rm;
        { float a = fmaxf(fmaxf(p0[0], p0[1]), p1[0]), bq = fmaxf(fmaxf(p0[2], p0[3]), p1[1]); a = fmaxf(fmaxf(a, p1[2]), p1[3]);
#pragma unroll
          for (int r = 4; r < 16; r += 4) { a = fmaxf(fmaxf(a, p0[r]), p0[r + 1]); bq = fmaxf(fmaxf(bq, p0[r + 2]), p0[r + 3]); a = fmaxf(fmaxf(a, p1[r]), p1[r + 1]); bq = fmaxf(fmaxf(bq, p1[r + 2]), p1[r + 3]); }
          rm = fmaxf(a, bq); }
        { const auto rr = __builtin_amdgcn_permlane32_swap(__float_as_uint(rm), __float_as_uint(rm), false, false); rm = fmaxf(__uint_as_float(rr[0]), __uint_as_float(rr[1])); }
        if (__any(rm > 8.f)) {
            const float dl = fmaxf(rm, 0.f), f = __builtin_amdgcn_exp2f(-dl);
            lsum *= f; mrun += dl;
#pragma unroll
            for (int r = 0; r < 16; ++r) { p0[r] -= dl; p1[r] -= dl; }
            if (hi == 0) wsf[r32] = f;
            asm volatile("s_waitcnt lgkmcnt(0)" ::: "memory");
#pragma unroll
            for (int r = 0; r < 16; ++r) { const float fr_ = wsf[crow(r, hi)]; o[0][r] *= fr_; o[1][r] *= fr_; }
        }
        float ps = 0.f;
#pragma unroll
        for (int r = 0; r < 16; ++r) { p0[r] = __builtin_amdgcn_exp2f(p0[r]); p1[r] = __builtin_amdgcn_exp2f(p1[r]); ps += p0[r] + p1[r]; }
        lsum += ps;
        u32x4 pw[4]; pack_p(pw, p0, p1);
        ATT_SBAR(); pv_r(o, vl, vu, pw);
        if (i + 1 < NT) tile_store(tst, shm + LDS_KV + ((i + 1) & 1) * KVBUF, wid, lane);
    };
    for (int i2 = 0; i2 < NT; i2 += 2) { step(i2, tlA, tlB); if (i2 + 1 < NT) step(i2 + 1, tlB, tlA); }
    { const auto rr = __builtin_amdgcn_permlane32_swap(__float_as_uint(lsum), __float_as_uint(lsum), false, false); lsum = __uint_as_float(rr[0]) + __uint_as_float(rr[1]); }
    if (hi == 0) wsf[32 + r32] = lsum;
    asm volatile("s_waitcnt lgkmcnt(0)" ::: "memory");
#pragma unroll
    for (int r = 0; r < 16; ++r) { const float rl = __builtin_amdgcn_rcpf(wsf[32 + crow(r, hi)]); o[0][r] *= rl; o[1][r] *= rl; }
    store_o(o, (bf16_t*)((unsigned char*)OC + (rowbase + t0 + 32 * (wid & 1)) * 1024 + 512 + h * 64), 1024, shm + LDS_OST + wid * 4096, lane, r32, hi);
    __syncthreads();
}

constexpr int SA2_LDS_KV = 0, SA2_LDS_OST = 4 * KVBUF, SA2_LDS_WS = SA2_LDS_OST + 8 * 4096, SA2_LDS_MASK = SA2_LDS_WS + 8 * 256, SA2_LDS_BYTES = SA2_LDS_MASK + 64 * MASK_STRIDE * 4;
__device__ __forceinline__ void sa_unit2(int b, int g, int qb, const bf16_t* __restrict__ Q, const bf16_t* __restrict__ K, const bf16_t* __restrict__ V, const unsigned* __restrict__ MASK,
                                         bf16_t* __restrict__ OC, LAS char* shm) {
    int tid_ = threadIdx.x; asm volatile("" : "+v"(tid_));
    const int tid = tid_, lane = tid & 63, r32 = lane & 31, hi = lane >> 5; const int wid = __builtin_amdgcn_readfirstlane(tid >> 6);
    const size_t rowbase = (size_t)b * SEQ; const int t0 = qb * 64, h = 4 * g + (wid >> 1), qloc = 32 * (wid & 1) + r32, t = t0 + qloc;
    const bf16_t* Qw = Q + (rowbase + t0 + 32 * (wid & 1)) * 512 + h * 64;
    const bf16_t* Kh = K + rowbase * 128 + g * 64; const bf16_t* Vh = V + rowbase * 128 + g * 64;
    bf16x8 qr[4];
#pragma unroll
    for (int d0 = 0; d0 < 4; ++d0) qr[d0] = *(const bf16x8*)(Qw + (size_t)r32 * 512 + d0 * 16 + hi * 8);
    LAS unsigned* mk = (LAS unsigned*)(shm + SA2_LDS_MASK);
#pragma unroll
    for (int i = 0; i < 8; ++i) { const int e = tid + i * 512, q = e >> 6, w = e & 63; mk[q * MASK_STRIDE + w] = MASK[(rowbase + t0 + q) * 64 + w]; }
    LAS float* wsf = (LAS float*)(shm + SA2_LDS_WS + wid * 256);
    const int NT = qb + 1;
    const float slope2 = __builtin_amdgcn_exp2f(-(float)(h + 1)) * 1.4426950408889634f; const f32x2 d2v = (f32x2){2.f * slope2, 2.f * slope2}, d6v = (f32x2){6.f * slope2, 6.f * slope2};
    f32x16 o[2]; o[0] = f32x16{}; o[1] = f32x16{};
    float mrun = -1600.f, lsum = 0.f;
    lds_cptr kvb = (lds_cptr)(shm + SA2_LDS_KV);
    lds_cptr vrd = kvb + 8192 + ((lane >> 4) & 1) * 32 + (lane & 3) * 8 + (4 * hi + ((lane & 15) >> 2)) * 64;
    lds_cptr krd = kvb + hi * 1024 + r32 * 16;
    LAS const unsigned* mkq = mk + qloc * MASK_STRIDE;
    TileLd tlA;
    { TileLd tl0, tl1;
      tile_load(tl0, Kh, Vh, 128, (NT - 1) * 64, wid, lane);
      if (NT > 1) tile_load(tl1, Kh, Vh, 128, (NT - 2) * 64, wid, lane);
      if (NT > 2) tile_load(tlA, Kh, Vh, 128, (NT - 3) * 64, wid, lane);
      tile_store(tl0, shm + SA2_LDS_KV, wid, lane);
      if (NT > 1) tile_store(tl1, shm + SA2_LDS_KV + KVBUF, wid, lane); }
    f32x16 X0, X1, Y0, Y1;
    bf16x8 kr[3]; s16x4 vlr[3], vur[3]; u32x4 pw[4];
#define SA2_MW(st) const int jtc_ = (NT - 1 - (st)) < 0 ? 0 : (NT - 1 - (st)); const u32x2 mw_ = *(LAS const u32x2*)(mkq + 2 * jtc_); \
        const unsigned w0_ = mw_.x >> (4 * hi), w1_ = mw_.y >> (4 * hi); const float base_ = slope2 * (float)(64 * jtc_ + 4 * hi - t) - mrun; f32x2 bvr_ = (f32x2){base_, base_ + slope2};
#define SA2_CI(C, r, w, add) { const int cb_ = ((r) & 3) + 8 * ((r) >> 2); const unsigned m_ = (unsigned)__builtin_amdgcn_sbfe((int)(w), cb_, 1), n_ = (unsigned)__builtin_amdgcn_sbfe((int)(w), cb_ + 1, 1); \
        const f32x2 bv_ = bvr_; bvr_ += ((r) & 2) ? d6v : d2v; float cv_, dv_;       \
        asm("v_bfi_b32 %0, %1, %2, %3" : "=v"(cv_) : "v"(m_), "v"(bv_.x), "v"(negbig)); asm("v_bfi_b32 %0, %1, %2, %3" : "=v"(dv_) : "v"(n_), "v"(bv_.y), "v"(negbig)); C[r] = cv_; C[(r) + 1] = dv_; }
#define SA2_MAX(C0, C1, rm) { float a_ = fmaxf(fmaxf(C0[0], C0[1]), C1[0]), b_ = fmaxf(fmaxf(C0[2], C0[3]), C1[1]); a_ = fmaxf(fmaxf(a_, C1[2]), C1[3]); \
        _Pragma("unroll") for (int r = 4; r < 16; r += 4) { a_ = fmaxf(fmaxf(a_, C0[r]), C0[r + 1]); b_ = fmaxf(fmaxf(b_, C0[r + 2]), C0[r + 3]); a_ = fmaxf(fmaxf(a_, C1[r]), C1[r + 1]); b_ = fmaxf(fmaxf(b_, C1[r + 2]), C1[r + 3]); } \
        rm = fmaxf(a_, b_); const auto rr_ = __builtin_amdgcn_permlane32_swap(__float_as_uint(rm), __float_as_uint(rm), false, false); rm = fmaxf(__uint_as_float(rr_[0]), __uint_as_float(rr_[1])); }
#define SA2_DECIDE(C0, C1) { float rm_; SA2_MAX(C0, C1, rm_); resc = false; \
        if (__any(rm_ > 8.f)) { const float dl_ = fmaxf(rm_, 0.f), f_ = __builtin_amdgcn_exp2f(-dl_); lsum *= f_; mrun += dl_; \
            _Pragma("unroll") for (int r = 0; r < 16; ++r) { C0[r] -= dl_; C1[r] -= dl_; } \
            if (hi == 0) wsf[r32] = f_; resc = true; } }
#define SA2_RESC() { if (resc) { asm volatile("s_waitcnt lgkmcnt(0)" ::: "memory"); _Pragma("unroll") for (int r = 0; r < 16; ++r) { const float fr_ = wsf[crow(r, hi)]; o[0][r] *= fr_; o[1][r] *= fr_; } } }
#define SA2_KLD(slot, gi) kr[slot] = *(LAS const bf16x8*)(kb_ + ((gi) >> 1) * 2048 + ((gi) & 1) * 512)
#define SA2_VIDX(gi) ((((gi) & 1) * 4) + ((gi) >> 1))
#define SA2_VLD(slot, gi) { vlr[slot] = vtr(vb_ + (SA2_VIDX(gi) >> 2) * 4096 + (SA2_VIDX(gi) & 3) * 1024); vur[slot] = vtr(vb_ + (SA2_VIDX(gi) >> 2) * 4096 + (SA2_VIDX(gi) & 3) * 1024 + 512); }
    bool resc = false;
    const float negbig = -1e30f;
    __syncthreads();
    { SA2_MW(0)
#pragma unroll
      for (int r = 0; r < 16; r += 2) SA2_CI(X0, r, w0_, 0)
#pragma unroll
      for (int r = 0; r < 16; r += 2) SA2_CI(X1, r, w1_, 32)
      { bf16x8 kf[8]; kload8(kf, kvb, r32, hi); ATT_SBAR(); qkt_r(X0, X1, kf, qr); }
      SA2_DECIDE(X0, X1)
#pragma unroll
      for (int r = 0; r < 16; ++r) { X0[r] = __builtin_amdgcn_exp2f(X0[r]); X1[r] = __builtin_amdgcn_exp2f(X1[r]); }
      if (NT > 1) { SA2_MW(1)
#pragma unroll
          for (int r = 0; r < 16; r += 2) SA2_CI(Y0, r, w0_, 0)
#pragma unroll
          for (int r = 0; r < 16; r += 2) SA2_CI(Y1, r, w1_, 32) }
      if (NT > 2) tile_store(tlA, shm + SA2_LDS_KV + 2 * KVBUF, wid, lane);
    }
#define SA2_GAPA(gi, C, s0, s1, s2, s3, pk) { \
        C = __builtin_amdgcn_mfma_f32_32x32x16_bf16(kr[(gi) % 3], qr[(gi) >> 1], C, 0, 0, 0); \
        if ((gi) + 3 < 8) SA2_KLD((gi) % 3, (gi) + 3); \
        sacc += (f32x2){s0, s1}; if ((gi) < 7) sacc += (f32x2){s2, s3}; asm volatile("" : "+v"(sacc)); pk; asm volatile("" : "+v"(pw[(gi) >> 1])); ATT_SBAR(); }
#define SA2_GAPB(gi, C, cb0, Pn, wn, addn) { \
        o[(gi) & 1] = __builtin_amdgcn_mfma_f32_32x32x16_bf16(__builtin_bit_cast(bf16x8, pw[(gi) >> 1]), (bf16x8){vlr[(gi) % 3][0], vlr[(gi) % 3][1], vlr[(gi) % 3][2], vlr[(gi) % 3][3], \
            vur[(gi) % 3][0], vur[(gi) % 3][1], vur[(gi) % 3][2], vur[(gi) % 3][3]}, o[(gi) & 1], 0, 0, 0); \
        if ((gi) + 3 < 8) SA2_VLD((gi) % 3, (gi) + 3) \
        C[cb0] = __builtin_amdgcn_exp2f(C[cb0]); C[cb0 + 1] = __builtin_amdgcn_exp2f(C[cb0 + 1]); C[cb0 + 2] = __builtin_amdgcn_exp2f(C[cb0 + 2]); C[cb0 + 3] = __builtin_amdgcn_exp2f(C[cb0 + 3]); \
        SA2_CI(Pn, cb0, wn, addn) SA2_CI(Pn, cb0 + 2, wn, addn) asm volatile("" : "+v"(C), "+v"(Pn)); ATT_SBAR(); }
#define SA2_STEP(I, C0, C1, P0, P1) { const int i = (I); \
        __syncthreads(); \
        if (i + 2 < NT) tile_load(tlA, Kh, Vh, 128, (NT - 3 - i) * 64, wid, lane); \
        lds_cptr kb_ = krd + (i & 3) * KVBUF; lds_cptr vb_ = vrd + ((i - 1) & 3) * KVBUF; \
        SA2_KLD(0, 0); SA2_KLD(1, 1); SA2_KLD(2, 2); \
        f32x2 sacc = (f32x2){P0[0], P0[1]}; ATT_SBAR(); \
        SA2_GAPA(0, C0, P0[2], P0[3], P0[4], P0[5],     (pw[0].x = cvtpk(P0[0], P0[1]), pw[0].y = cvtpk(P0[2], P0[3]))) \
        SA2_GAPA(1, C1, P0[6], P0[7], P0[8], P0[9],     (pw[0].z = cvtpk(P0[4], P0[5]), pw[0].w = cvtpk(P0[6], P0[7]))) \
        SA2_GAPA(2, C0, P0[10], P0[11], P0[12], P0[13], (pw[1].x = cvtpk(P0[8], P0[9]), pw[1].y = cvtpk(P0[10], P0[11]))) \
        SA2_GAPA(3, C1, P0[14], P0[15], P1[0], P1[1],   (pw[1].z = cvtpk(P0[12], P0[13]), pw[1].w = cvtpk(P0[14], P0[15]))) \
        SA2_GAPA(4, C0, P1[2], P1[3], P1[4], P1[5],     (pw[2].x = cvtpk(P1[0], P1[1]), pw[2].y = cvtpk(P1[2], P1[3]))) \
        SA2_GAPA(5, C1, P1[6], P1[7], P1[8], P1[9],     (pw[2].z = cvtpk(P1[4], P1[5]), pw[2].w = cvtpk(P1[6], P1[7]))) \
        SA2_GAPA(6, C0, P1[10], P1[11], P1[12], P1[13], (pw[3].x = cvtpk(P1[8], P1[9]), pw[3].y = cvtpk(P1[10], P1[11]))) \
        SA2_GAPA(7, C1, P1[14], P1[15], 0.f, 0.f,       (pw[3].z = cvtpk(P1[12], P1[13]), pw[3].w = cvtpk(P1[14], P1[15]))) \
        lsum += sacc.x + sacc.y; \
        SA2_VLD(0, 0) SA2_VLD(1, 1) SA2_VLD(2, 2) ATT_SBAR(); \
        SA2_DECIDE(C0, C1) \
        SA2_MW(i + 1) ATT_SBAR(); \
        SA2_GAPB(0, C0, 0,  P0, w0_, 0)  SA2_GAPB(1, C0, 4,  P0, w0_, 0)  SA2_GAPB(2, C0, 8,  P0, w0_, 0)  SA2_GAPB(3, C0, 12, P0, w0_, 0) \
        SA2_GAPB(4, C1, 0,  P1, w1_, 32) SA2_GAPB(5, C1, 4,  P1, w1_, 32) SA2_GAPB(6, C1, 8,  P1, w1_, 32) SA2_GAPB(7, C1, 12, P1, w1_, 32) \
        SA2_RESC() \
        if (i + 2 < NT) tile_store(tlA, shm + SA2_LDS_KV + ((i + 2) & 3) * KVBUF, wid, lane); }
    for (int i2 = 1; i2 < NT; i2 += 2) {
        SA2_STEP(i2, Y0, Y1, X0, X1)
        if (i2 + 1 < NT) SA2_STEP(i2 + 1, X0, X1, Y0, Y1)
    }
    { __syncthreads();
      s16x4 vl[8], vu[8]; vload16(vl, vu, kvb + ((NT - 1) & 3) * KVBUF + 8192, lane, hi);
      float ps = 0.f;
      if (NT & 1) {
#pragma unroll
          for (int r = 0; r < 16; ++r) ps += X0[r] + X1[r];
          pack_p(pw, X0, X1);
      } else {
#pragma unroll
          for (int r = 0; r < 16; ++r) ps += Y0[r] + Y1[r];
          pack_p(pw, Y0, Y1);
      }
      lsum += ps;
      pv_r(o, vl, vu, pw);
    }
    { const auto rr = __builtin_amdgcn_permlane32_swap(__float_as_uint(lsum), __float_as_uint(lsum), false, false); lsum = __uint_as_float(rr[0]) + __uint_as_float(rr[1]); }
    if (hi == 0) wsf[32 + r32] = lsum;
    asm volatile("s_waitcnt lgkmcnt(0)" ::: "memory");
#pragma unroll
    for (int r = 0; r < 16; ++r) { const float rl = __builtin_amdgcn_rcpf(wsf[32 + crow(r, hi)]); o[0][r] *= rl; o[1][r] *= rl; }
    store_o(o, (bf16_t*)((unsigned char*)OC + (rowbase + t0 + 32 * (wid & 1)) * 1024 + 512 + h * 64), 1024, shm + SA2_LDS_OST + wid * 4096, lane, r32, hi);
    __syncthreads();
#undef SA2_MW
#undef SA2_CI
#undef SA2_MAX
#undef SA2_DECIDE
#undef SA2_RESC
#undef SA2_GAPA
#undef SA2_GAPB
#undef SA2_STEP
#undef SA2_KLD
#undef SA2_VIDX
#undef SA2_VLD
}
}

constexpr int NWAVES = 8;
constexpr int RING_BYTES = 131072, LDSCTL_OFF = RING_BYTES, MISC_OFF = LDSCTL_OFF + 320, LDS_BYTES = 147456;
static_assert(att::LDS_ATT_BYTES <= RING_BYTES && att::SA2_LDS_BYTES <= RING_BYTES, "attention LDS");
#define RLX_AGENT __ATOMIC_RELAXED, __HIP_MEMORY_SCOPE_AGENT
#define XB_TMO      128
#define XB_XCNT(j)  (256  + 64 * (j))
#define XB_XSUB(j)  (1280 + 64 * (j))
#define XB_XGEN(j)  (2304 + 64 * (j))
#define XB_TOP      3328
#define XB_TOPGEN   3392
#define XCD_BAR_WORDS 3456
#define XB_SPIN_CAP (1u << 18)
__device__ __forceinline__ unsigned xb_ld(unsigned* p)              { return __hip_atomic_load(p, __ATOMIC_RELAXED, __HIP_MEMORY_SCOPE_AGENT); }
__device__ __forceinline__ unsigned xb_add(unsigned* p, unsigned v) { return __hip_atomic_fetch_add(p, v, __ATOMIC_RELAXED, __HIP_MEMORY_SCOPE_AGENT); }
__device__ __forceinline__ unsigned xb_xcc_id() { return (unsigned)__builtin_amdgcn_s_getreg((3 << 11) | 20) & 0xFu; }
#define XB_SPIN(cond, bar) do { unsigned _sp = 0; while (cond) { __builtin_amdgcn_s_sleep(1); \
    if ((++_sp & 255u) == 0u) { if (xb_ld(&(bar)[XB_TMO])) break; if (_sp > XB_SPIN_CAP) { atomicAdd(&(bar)[XB_TMO], 1u); break; } } } } while (0)
struct XcdBarrier { unsigned* bar; unsigned x; volatile LAS unsigned* st; };
__device__ __forceinline__ XcdBarrier xcd_barrier_post(unsigned* bar, volatile LAS unsigned* st) {
    XcdBarrier b; b.bar = bar; b.x = xb_xcc_id(); b.st = st;
    if (threadIdx.x == 0) (void)xb_add(&bar[XB_XCNT(b.x)], 1u);
    return b;
}
__device__ __forceinline__ void xcd_barrier_complete(unsigned* bar, unsigned x, unsigned& nloc, unsigned& nx) {
    const unsigned G = gridDim.x * gridDim.y * gridDim.z;
    unsigned sum, cnt, mine, sp = 0u;
    for (;;) {
        sum = 0u; cnt = 0u; mine = 0u;
#pragma unroll
        for (unsigned j = 0; j < 16; ++j) { const unsigned c = xb_ld(&bar[XB_XCNT(j)]); sum += c; cnt += (c > 0u) ? 1u : 0u; mine = (j == x) ? c : mine; }
        if (sum == G) break;
        __builtin_amdgcn_s_sleep(1);
        if ((++sp & 255u) == 0u) { if (xb_ld(&bar[XB_TMO])) break; if (sp > XB_SPIN_CAP) { atomicAdd(&bar[XB_TMO], 1u); break; } }
    }
    nloc = mine > 0u ? mine : 1u; nx = cnt > 0u ? cnt : 1u;
}
template <bool LOCAL = false>
__device__ __forceinline__ void xcd_barrier(const XcdBarrier& b) {
    asm volatile("s_waitcnt vmcnt(0)" ::: "memory");
    __syncthreads();
    if (threadIdx.x == 0) {
        unsigned* bar = b.bar;
        __builtin_amdgcn_s_waitcnt(0);
        unsigned nloc = b.st[0], nx = b.st[1];
        if (nloc == 0u) { xcd_barrier_complete(bar, b.x, nloc, nx); b.st[0] = nloc; b.st[1] = nx; }
        const unsigned old = xb_add(&bar[XB_XSUB(b.x)], 1u);
        const unsigned gen = old / nloc;
        if (old + 1u == (gen + 1u) * nloc) {
            if constexpr (!LOCAL) __builtin_amdgcn_fence(__ATOMIC_RELEASE, "agent");
            asm volatile("s_waitcnt vmcnt(0)" ::: "memory");
            if constexpr (!LOCAL) {
                const unsigned og = xb_add(&bar[XB_TOP], 1u);
                const unsigned tg = og / nx;
                if (og + 1u == (tg + 1u) * nx) xb_add(&bar[XB_TOPGEN], 1u);
                else XB_SPIN(xb_ld(&bar[XB_TOPGEN]) == tg, bar);
            }
            __builtin_amdgcn_fence(__ATOMIC_ACQUIRE, "agent");
            xb_add(&bar[XB_XGEN(b.x)], 1u);
            asm volatile("s_waitcnt vmcnt(0)" ::: "memory");
        } else {
            XB_SPIN(xb_ld(&bar[XB_XGEN(b.x)]) == gen, bar);
            __builtin_amdgcn_fence(__ATOMIC_ACQUIRE, "agent");
            asm volatile("s_waitcnt vmcnt(0)" ::: "memory");
        }
    }
    __syncthreads();
}

__device__ __forceinline__ void wait_count(unsigned* p, unsigned target) {
    if (threadIdx.x == 0) { unsigned sp = 0; while (xb_ld(p) < target) { __builtin_amdgcn_s_sleep(2); if (++sp > (1u << 22)) break; }
        __builtin_amdgcn_fence(__ATOMIC_ACQUIRE, "agent"); asm volatile("s_waitcnt vmcnt(0)" ::: "memory"); }
    __syncthreads();
}
__device__ __forceinline__ float wave_sum(float v) {
#pragma unroll
    for (int o = 1; o < 64; o <<= 1) v += __shfl_xor(v, o);
    return v;
}
__device__ __forceinline__ void transpose_item(const float* __restrict__ W, int ldw, int sk0, int srccol, const float* __restrict__ kscale, bf16_t* __restrict__ WT, int dK, int drow0, int dk0, LAS float* scr, int lane) {
    float v[32];
    const float* wp = W + (size_t)(sk0 + (lane >> 5)) * ldw + (srccol >= 0 ? srccol : 0);
#pragma unroll
    for (int i = 0; i < 32; ++i) v[i] = (srccol >= 0) ? wp[(size_t)(2 * i) * ldw] : 0.f;
    if (kscale) {
#pragma unroll
        for (int i = 0; i < 32; ++i) v[i] *= kscale[sk0 + 2 * i + (lane >> 5)];
    }
#pragma unroll
    for (int i = 0; i < 32; ++i) scr[(2 * i + (lane >> 5)) * 33 + (lane & 31)] = v[i];
    asm volatile("s_waitcnt lgkmcnt(0)" ::: "memory");
    const int c = lane & 7;
#pragma unroll
    for (int j = 0; j < 4; ++j) { const int n = (lane >> 3) + 8 * j; const LAS float* s = scr + (8 * c) * 33 + n;
        u32x4 o; o.x = cvtpk(s[0 * 33], s[1 * 33]); o.y = cvtpk(s[2 * 33], s[3 * 33]); o.z = cvtpk(s[4 * 33], s[5 * 33]); o.w = cvtpk(s[6 * 33], s[7 * 33]);
        *(u32x4*)(WT + (size_t)(drow0 + n) * dK + dk0 + 8 * c) = o; }
    asm volatile("s_waitcnt lgkmcnt(0)" ::: "memory");
}
__device__ __forceinline__ void transpose_item_fp8(const float* __restrict__ W, int ldw, int sk0, int srccol, float scale, unsigned char* __restrict__ WT, int dK, int drow0, int dk0, LAS float* scr, int lane, const float* __restrict__ kscale = nullptr) {
    float v[32];
    const float* wp = W + (size_t)(sk0 + (lane >> 5)) * ldw + srccol;
#pragma unroll
    for (int i = 0; i < 32; ++i) v[i] = wp[(size_t)(2 * i) * ldw];
    if (kscale) {
#pragma unroll
        for (int i = 0; i < 32; ++i) v[i] *= kscale[sk0 + 2 * i + (lane >> 5)];
    }
#pragma unroll
    for (int i = 0; i < 32; ++i) scr[(2 * i + (lane >> 5)) * 33 + (lane & 31)] = __builtin_amdgcn_fmed3f(v[i] * scale, -448.f, 448.f);
    asm volatile("s_waitcnt lgkmcnt(0)" ::: "memory");
    const int c = lane & 7;
#pragma unroll
    for (int j = 0; j < 4; ++j) { const int n = (lane >> 3) + 8 * j; const LAS float* s = scr + (8 * c) * 33 + n;
        u32x2 o; o.x = pk4_fp8(s[0 * 33], s[1 * 33], s[2 * 33], s[3 * 33]); o.y = pk4_fp8(s[4 * 33], s[5 * 33], s[6 * 33], s[7 * 33]);
        *(u32x2*)(WT + (size_t)(drow0 + n) * dK + dk0 + 8 * c) = o; }
    asm volatile("s_waitcnt lgkmcnt(0)" ::: "memory");
}
struct TItem { const float* W; int ldw, sk0, srccol; float scale; unsigned char* WT; int dK, drow0, dk0; const float* kscale; };
__device__ __forceinline__ void titem_load(const TItem& t, float (&v)[32], int lane) {
    const float* wp = t.W + (size_t)(t.sk0 + (lane >> 5)) * t.ldw + t.srccol;
#pragma unroll
    for (int i = 0; i < 32; ++i) v[i] = wp[(size_t)(2 * i) * t.ldw];
}
__device__ __forceinline__ void titem_finish(const TItem& t, float (&v)[32], LAS float* scr, int lane) {
    if (t.kscale) {
#pragma unroll
        for (int i = 0; i < 32; ++i) v[i] *= t.kscale[t.sk0 + 2 * i + (lane >> 5)];
    }
#pragma unroll
    for (int i = 0; i < 32; ++i) scr[(2 * i + (lane >> 5)) * 33 + (lane & 31)] = __builtin_amdgcn_fmed3f(v[i] * t.scale, -448.f, 448.f);
    asm volatile("s_waitcnt lgkmcnt(0)" ::: "memory");
    const int c = lane & 7;
#pragma unroll
    for (int j = 0; j < 4; ++j) { const int n = (lane >> 3) + 8 * j; const LAS float* sp = scr + (8 * c) * 33 + n;
        u32x2 o; o.x = pk4_fp8(sp[0 * 33], sp[1 * 33], sp[2 * 33], sp[3 * 33]); o.y = pk4_fp8(sp[4 * 33], sp[5 * 33], sp[6 * 33], sp[7 * 33]);
        *(u32x2*)(t.WT + (size_t)(t.drow0 + n) * t.dK + t.dk0 + 8 * c) = o; }
    asm volatile("s_waitcnt lgkmcnt(0)" ::: "memory");
}
__device__ __forceinline__ int win_srccol(int j) { return j < 2600 ? j : (j < 2816 ? -1 : j - 216); }

struct Args { const float* in[13]; float* out; unsigned char* ws; int ph_lo, ph_hi; };

__global__ void __launch_bounds__(NWAVES * 64, 2) mk_fwd(Args args) {
    extern __shared__ __attribute__((aligned(16))) unsigned char lds_raw[];
    LAS unsigned char* lds = (LAS unsigned char*)lds_raw;
    volatile LAS unsigned* MISC = (volatile LAS unsigned*)(lds + MISC_OFF);
    const int tid = threadIdx.x, lane = tid & 63; const int wave = __builtin_amdgcn_readfirstlane(tid >> 6);
    const int G = gridDim.x; const int bx = blockIdx.x; const int vcu = (G % 8 == 0) ? (bx % 8) * (G / 8) + bx / 8 : bx;
    unsigned char* ws = args.ws;
    unsigned* ctl = (unsigned*)(ws + WS_CTL);
    const float* x = args.in[0];
#define WIN ((bf16_t*)(args.ws + WS_WIN))
#define WCAT ((bf16_t*)(args.ws + WS_WCAT))
#define WOUT ((bf16_t*)(args.ws + WS_WOUT))
#define W1T ((bf16_t*)(args.ws + WS_W1))
#define W2T ((bf16_t*)(args.ws + WS_W2))
#define XN ((bf16_t*)(args.ws + WS_XN))
#define QSB ((bf16_t*)(args.ws + WS_QSB))
#define KSB ((bf16_t*)(args.ws + WS_KSB))
#define VSB ((bf16_t*)(args.ws + WS_VSB))
#define QSA ((bf16_t*)(args.ws + WS_QSA))
#define KSA ((bf16_t*)(args.ws + WS_KSA))
#define VSA ((bf16_t*)(args.ws + WS_VSA))
#define QIX ((bf16_t*)(args.ws + WS_QIX))
#define KIX ((bf16_t*)(args.ws + WS_KIX))
#define WIX ((float*)(args.ws + WS_WIX))
#define MASK ((unsigned*)(args.ws + WS_MASK))
#define G1 ((bf16_t*)(args.ws + WS_G1))
#define G2 ((bf16_t*)(args.ws + WS_G2))
#define OCAT ((bf16_t*)(args.ws + WS_OCAT))
#define SSQ ((float*)(args.ws + WS_SSQ))
#define MG ((bf16_t*)(args.ws + WS_MG))
#define U ((bf16_t*)(args.ws + WS_U))
    for (int u = tid; u < (LDS_BYTES - LDSCTL_OFF) / 4; u += NWAVES * 64) ((LAS unsigned*)(lds + LDSCTL_OFF))[u] = 0u;
    __syncthreads();
    const int lo = args.ph_lo, hi = args.ph_hi;
    const bool one_launch = (hi - lo) > 1;
    XcdBarrier bar; bar.bar = ctl + CW_BAR; bar.x = 0; bar.st = nullptr;
    if (one_launch) bar = xcd_barrier_post(ctl + CW_BAR, MISC + 8);
    if (one_launch && tid == 0) __hip_atomic_store(ctl + CW_XCC + bx, xb_xcc_id() + 1u, __ATOMIC_RELAXED, __HIP_MEMORY_SCOPE_AGENT);
    bool local_ok = false;
#ifndef PH_MASK
#define PH_MASK 0xff
#endif
#define IN(k) (((PH_MASK >> (k)) & 1) && lo <= (k) && (k) < hi)
#ifndef REPEAT_MASK
#define REPEAT_MASK 0
#endif
#define REPS(k) ((((REPEAT_MASK) >> (k)) & 1) ? 2 : 1)
#ifndef DUP_MASK
#define DUP_MASK 0
#endif
#define DUPS(k) ((((DUP_MASK) >> (k)) & 1) ? 2 : 1)
#define SEAM(k) do { if (IN(k) && IN((k) + 1)) xcd_barrier(bar); } while (0)
#define SEAM_L(k) do { if (IN(k) && IN((k) + 1)) { if (local_ok) xcd_barrier<true>(bar); else xcd_barrier(bar); } } while (0)

    if (IN(0)) for (int rep_ = 0; rep_ < REPS(0); ++rep_) {
        LAS float* scr = (LAS float*)(lds + wave * 16384);
        const int gw = vcu * NWAVES + wave, NGW = G * NWAVES;
        constexpr int I_IN = (DM / 64) * (NPROJ_A / 32), I_G = (DM / 64) * (NGATE / 32);
        for (int it = gw; it < I_IN + I_G; it += NGW) {
            if (it < I_IN) { const int nblk = NPROJ_A / 32, kb = it / nblk, nb = it % nblk; const int jr = 32 * nb + (lane & 31); transpose_item(args.in[2], PROJ_W, 64 * kb, win_srccol(256 * tile_a(jr >> 8) + (jr & 255)), args.in[1], WIN, DM, 32 * nb, 64 * kb, scr, lane); }
            else { const int r = it - I_IN, nblk = NGATE / 32, kb = r / nblk, nb = r % nblk; const int jr = 32 * nb + (lane & 31); transpose_item_fp8(args.in[2], PROJ_W, 64 * kb, win_srccol(256 * tile_b(jr >> 8) + (jr & 255)), GATE_WSCALE, (unsigned char*)(args.ws + WS_WG8), DM, 32 * nb, 64 * kb, scr, lane, args.in[1]); }
        }
        if (one_launch && rep_ == 0) {
            asm volatile("s_waitcnt vmcnt(0)" ::: "memory"); __syncthreads();
            if (tid == 0) { __builtin_amdgcn_fence(__ATOMIC_RELEASE, "agent"); asm volatile("s_waitcnt vmcnt(0)" ::: "memory"); xb_add(ctl + CW_WINREADY, 1u); }
        }
        const int m0 = (G == 256) ? (bx & 7) * SEQ + 2 * ((bx >> 3) * NWAVES + wave) : 2 * gw, mstep = (G == 256) ? 2 * (G / 8) * NWAVES : 2 * NGW, mend = (G == 256) ? ((bx & 7) + 1) * SEQ : M;
        for (int m = m0; m < mend; m += mstep) {
            const f32x4* xr = (const f32x4*)(x + (size_t)m * DM) + lane; f32x4 v[2][4]; float s0 = 0.f, s1 = 0.f;
#pragma unroll
            for (int j = 0; j < 4; ++j) { v[0][j] = xr[64 * j]; v[1][j] = xr[256 + 64 * j]; }
#pragma unroll
            for (int j = 0; j < 4; ++j) { s0 += (v[0][j][0] * v[0][j][0] + v[0][j][1] * v[0][j][1]) + (v[0][j][2] * v[0][j][2] + v[0][j][3] * v[0][j][3]);
                                          s1 += (v[1][j][0] * v[1][j][0] + v[1][j][1] * v[1][j][1]) + (v[1][j][2] * v[1][j][2] + v[1][j][3] * v[1][j][3]); }
            const float rs0 = __builtin_amdgcn_rsqf(wave_sum(s0) * (1.f / DM) + EPS), rs1 = __builtin_amdgcn_rsqf(wave_sum(s1) * (1.f / DM) + EPS);
            u32x2* o8 = (u32x2*)(XN + (size_t)m * DM) + lane;
            if (lane == 0) { float* rsd = (float*)(args.ws + WS_RSTD); rsd[m] = rs0; rsd[m + 1] = rs1; }
#pragma unroll
            for (int j = 0; j < 4; ++j) { const f32x4 x0 = v[0][j], x1_ = v[1][j]; const f32x4 y0 = x0 * rs0, y1 = x1_ * rs1;
                u32x2 w0, w1; w0.x = cvtpk(x0[0], x0[1]); w0.y = cvtpk(x0[2], x0[3]); w1.x = cvtpk(x1_[0], x1_[1]); w1.y = cvtpk(x1_[2], x1_[3]); o8[64 * j] = w0; o8[256 + 64 * j] = w1;
                unsigned* o4 = (unsigned*)(args.ws + WS_XN8 + (size_t)m * DM) + lane; o4[64 * j] = pk4_fp8_nc(y0[0], y0[1], y0[2], y0[3]); o4[256 + 64 * j] = pk4_fp8_nc(y1[0], y1[1], y1[2], y1[3]); }
        }
    }
    if (IN(0) && IN(1)) {
        wait_count(ctl + CW_WINREADY, (unsigned)G);
        if (G == 256) {
            bool okl = true;
#pragma unroll
            for (int i = 0; i < 4; ++i) { const int w = lane + 64 * i; okl = okl && (__hip_atomic_load(ctl + CW_XCC + w, __ATOMIC_RELAXED, __HIP_MEMORY_SCOPE_AGENT) == __hip_atomic_load(ctl + CW_XCC + (w & 7), __ATOMIC_RELAXED, __HIP_MEMORY_SCOPE_AGENT)); }
            local_ok = __all(okl);
        }
        if (local_ok) xcd_barrier<true>(bar); else xcd_barrier(bar);
    }
    if (IN(1)) for (int rep_ = 0; rep_ < REPS(1); ++rep_) {
        LAS float* ptab = (LAS float*)(lds + LDSCTL_OFF + 4096); int ptab_pm0 = -1;
        { pg8::Gemm g{XN, WIN, M, NPROJ_A, DM}; pg8::StaticOrder S; S.init(M, NPROJ_A, G, bx, DUPS(1));
          { pg8::Unit u0; if (S.next(0, u0)) ptab_pm0 = u0.pm;
            if (tid < 256) { if (ptab_pm0 >= 0) ptab[tid] = ((const float*)(args.ws + WS_RSTD))[256 * ptab_pm0 + tid]; }
            else { const int i = tid - 256, w = i >> 6, d = i & 63; ptab[256 + i] = (w == 0 ? args.in[3][d] * C2 : w == 1 ? args.in[4][d] : w == 2 ? args.in[5][d] * C2 : args.in[6][d]); }
            __syncthreads(); }
          pg8::EpiProj E{QSB, KSB, VSB, QSA, KSA, VSA, QIX, KIX, G1, G2, WIX, ptab, ptab_pm0, (const float*)(args.ws + WS_RSTD), 0, -1.4426950408889634f, 1.f};
          pg8::gemm_phase<pg8::EpiProj, pg8::StaticOrder, true>(lds, g, S, E); }
        { pg8::Gemm g{(const bf16_t*)(args.ws + WS_XN8), (const bf16_t*)(args.ws + WS_WG8), M, NGATE, DM}; pg8::StaticOrder S; S.init(M, NGATE, G, bx, DUPS(1));
          pg8::EpiProj E{QSB, KSB, VSB, QSA, KSA, VSA, QIX, KIX, G1, G2, WIX, ptab, ptab_pm0, nullptr, 1, -1.4426950408889634f, 1.f / GATE_WSCALE};
          pg8::gemm_phase<pg8::EpiProj, pg8::StaticOrder, true, true>(lds, g, S, E); }
        { const int nfull = (M / 256) * (NGATE / 256) % G, nidle = (nfull == 0) ? G : G - nfull;
          const int first = (nfull == 0) ? 0 : nfull;
          if (bx >= first) {
              LAS float* scr = (LAS float*)(lds + wave * 16384);
              const int gw = (bx - first) * NWAVES + wave, NGW = nidle * NWAVES;
              constexpr int I_CAT = (1024 / 64) * (1024 / 32), I_OUT = I_CAT, I_1 = (DM / 64) * (FF / 32), I_2 = (FF / 64) * (DM / 32);
              auto decode = [&](int r) -> TItem {
                  if (r < I_CAT) { const int nblk = 1024 / 32, kb = r / nblk, nb = r % nblk;
                      return TItem{kb < 8 ? args.in[7] : args.in[8], 1024, 64 * (kb & 7), 32 * nb + (lane & 31), WCAT_SCALE, (unsigned char*)WCAT, 1024, 32 * nb, 64 * kb, nullptr}; } r -= I_CAT;
                  if (r < I_OUT) { const int nblk = 1024 / 32, kb = r / nblk, nb = r % nblk; return TItem{args.in[9], 1024, 64 * kb, 32 * nb + (lane & 31), WOUT_SCALE, (unsigned char*)WOUT, 1024, 32 * nb, 64 * kb, nullptr}; } r -= I_OUT;
                  if (r < I_1) { const int nblk = FF / 32, kb = r / nblk, nb = r % nblk; return TItem{args.in[11], FF, 64 * kb, 32 * nb + (lane & 31), W1_SCALE, (unsigned char*)W1T, DM, 32 * nb, 64 * kb, args.in[10]}; } r -= I_1;
                  { const int nblk = DM / 32, kb = r / nblk, nb = r % nblk; return TItem{args.in[12], DM, 64 * kb, 32 * nb + (lane & 31), W2_SCALE, (unsigned char*)W2T, FF, 32 * nb, 64 * kb, nullptr}; }
              };
              constexpr int I_ALL = I_CAT + I_OUT + I_1 + I_2;
              if (gw < I_ALL) {
                  int it = gw; TItem cur = decode(it); float v[32], nv[32]; titem_load(cur, v, lane);
#pragma unroll 1
                  for (;;) {
                      const int nx = it + NGW; const bool hn = nx < I_ALL; TItem nxt = decode(hn ? nx : it);
                      titem_load(nxt, nv, lane);
                      titem_finish(cur, v, scr, lane);
                      if (!hn) break;
                      cur = nxt; it = nx;
#pragma unroll
                      for (int i = 0; i < 32; ++i) v[i] = nv[i];
                  }
              }
          } }
    }
    SEAM_L(1);
    if (IN(2)) for (int rep_ = 0; rep_ < REPS(2); ++rep_) {
#pragma unroll 1
        for (int p2 = 2 * vcu; p2 < 512; p2 += ((p2 & 1) ? 2 * G - 1 : 1)) { const int p = p2 >> 1, b = p >> 5, i = p & 31;
            const int qblk = (p2 & 1) ? i : 63 - i;
            idx::idx_unit(b, qblk, QIX, KIX, WIX, MASK, (LAS char*)lds + wave * 16384);
            __syncthreads();
            if (tid == 0) __hip_atomic_fetch_add(ctl + CW_MFLAG + 16 * (32 * b + (qblk >> 1)), 1u, __ATOMIC_RELAXED, __HIP_MEMORY_SCOPE_AGENT); }
    }
    if (IN(3)) for (int rep_ = 0; rep_ < REPS(3); ++rep_) {
        LAS char* shm = (LAS char*)lds;
        for (int p = vcu; p < 256; p += G) {
#pragma unroll 1
            for (int u2 = 0; u2 < 2; ++u2) { const int bp = p >> 3, Ri = p & 7; att::sb_unit(bp >> 2, bp & 3, u2 ? Ri : 15 - Ri, QSB, KSB, VSB, OCAT, shm); }
#pragma unroll 1
            for (int u2 = 0; u2 < 2; ++u2) { const int bg = p >> 4, qi = p & 15, qb = u2 ? qi : 31 - qi;
                if (one_launch) {
                    if (tid == 0) { unsigned* fl = ctl + CW_MFLAG + 16 * (32 * (bg >> 1) + qb); unsigned sp = 0;
                        while (__hip_atomic_load(fl, __ATOMIC_RELAXED, __HIP_MEMORY_SCOPE_AGENT) < 2u) { __builtin_amdgcn_s_sleep(2); if (++sp > (1u << 22)) break; }
                        __builtin_amdgcn_fence(__ATOMIC_ACQUIRE, "agent"); asm volatile("s_waitcnt vmcnt(0)" ::: "memory"); }
                    __syncthreads(); }
                att::sa_unit2(bg >> 1, bg & 1, qb, QSA, KSA, VSA, MASK, OCAT, shm); }
        }
    }
    SEAM(3);
    if (IN(4)) for (int rep_ = 0; rep_ < REPS(4); ++rep_) {
        pg8::Gemm g{OCAT, WCAT, M, 1024, 1024}; pg8::StaticOrder S; S.init(M, 1024, G, bx, DUPS(4));
        pg8::EpiMerge E{(const unsigned char*)G1, (const unsigned char*)G2, MG};
        pg8::gemm_phase<pg8::EpiMerge, pg8::StaticOrder, true, true>(lds, g, S, E);
    }
    SEAM_L(4);
    if (IN(5)) for (int rep_ = 0; rep_ < REPS(5); ++rep_) {
        pg8::Gemm g{MG, WOUT, M, 1024, 1024}; pg8::StaticOrder S; S.init(M, 1024, G, bx, DUPS(5));
        pg8::EpiWout E{XN, SSQ, (unsigned char*)(args.ws + WS_X18)};
        pg8::gemm_phase<pg8::EpiWout, pg8::StaticOrder, true, true>(lds, g, S, E);
    }
    SEAM_L(5);
    if (IN(6)) for (int rep_ = 0; rep_ < REPS(6); ++rep_) {
        pg8::Gemm g{(const bf16_t*)(args.ws + WS_X18), W1T, M, FF, DM}; pg8::StaticOrder S; S.init(M, FF, G, bx, DUPS(6));
        LAS float* r2tab = (LAS float*)(lds + LDSCTL_OFF + 4096); int pm0 = -1;
        { pg8::Unit u0; if (S.next(0, u0)) { pm0 = u0.pm;
              if (tid < 256) { const f32x4* sp = (const f32x4*)(SSQ + (size_t)(256 * pm0 + tid) * 16); const f32x4 s0 = sp[0], s1 = sp[1], s2 = sp[2], s3 = sp[3]; const f32x4 st = (s0 + s1) + (s2 + s3);
                  r2tab[tid] = __builtin_amdgcn_rcpf(((st[0] + st[1]) + (st[2] + st[3])) * (1.f / 1024.f) + EPS) * (1.f / ((X1_SCALE * W1_SCALE) * (X1_SCALE * W1_SCALE))); } }
          __syncthreads(); }
        pg8::EpiUp E{SSQ, U, r2tab, pm0};
        pg8::gemm_phase<pg8::EpiUp, pg8::StaticOrder, true, true>(lds, g, S, E);
    }
    SEAM_L(6);
    if (IN(7)) {
        pg8::Gemm g{U, W2T, M, 1024, FF}; pg8::StaticOrder S; S.init(M, 1024, G, bx, DUPS(7));
        pg8::EpiDown E{XN, args.out};
        pg8::gemm_phase<pg8::EpiDown, pg8::StaticOrder, true, true>(lds, g, S, E);
    }
#ifdef EXTRA_BARRIERS
    for (int eb_ = 0; eb_ < EXTRA_BARRIERS; ++eb_) xcd_barrier(bar);
#endif
#undef IN
#undef SEAM
#undef WIN
#undef WCAT
#undef WOUT
#undef W1T
#undef W2T
#undef XN
#undef QSB
#undef KSB
#undef VSB
#undef QSA
#undef KSA
#undef VSA
#undef QIX
#undef KIX
#undef WIX
#undef MASK
#undef G1
#undef G2
#undef OCAT
#undef SSQ
#undef MG
#undef U
}

#if MK_DEBUG
namespace nv {
constexpr int TOPK = 256;
__device__ __forceinline__ float wave_sum(float v) {
#pragma unroll
    for (int o = 32; o > 0; o >>= 1) v += __shfl_xor(v, o);
    return v;
}
__device__ __forceinline__ float wave_max(float v) {
#pragma unroll
    for (int o = 32; o > 0; o >>= 1) v = fmaxf(v, __shfl_xor(v, o));
    return v;
}
__device__ __forceinline__ float softplusf(float z) { return fmaxf(z, 0.f) + log1pf(expf(-fabsf(z))); }
__global__ void k_rmsnorm(const float* __restrict__ x, const float* __restrict__ g, float* __restrict__ out, int rows, int D) {
    const int wave = (blockIdx.x * blockDim.x + threadIdx.x) >> 6, lane = threadIdx.x & 63;
    if (wave >= rows) return;
    const float* xr = x + (size_t)wave * D; float s = 0.f;
    for (int i = lane; i < D; i += 64) { const float v = xr[i]; s += v * v; }
    s = wave_sum(s);
    const float r = rsqrtf(s / (float)D + EPS);
    for (int i = lane; i < D; i += 64) out[(size_t)wave * D + i] = xr[i] * r * g[i];
}
__global__ void __launch_bounds__(256) k_gemm(const float* __restrict__ A, int lda, const float* __restrict__ B, int ldb, float* __restrict__ C, int ldc, int Mr, int N, int K) {
    __shared__ float As[16][64 + 4];
    __shared__ float Bs[16][64 + 4];
    const int tid = threadIdx.x, tx = tid & 15, ty = tid >> 4;
    const int m0 = blockIdx.y * 64, n0 = blockIdx.x * 64;
    float acc[4][4];
#pragma unroll
    for (int i = 0; i < 4; ++i)
#pragma unroll
        for (int j = 0; j < 4; ++j) acc[i][j] = 0.f;
    const int ar = tid >> 2, ak = (tid & 3) * 4, bk = tid >> 4, bn = (tid & 15) * 4;
    for (int k0 = 0; k0 < K; k0 += 16) {
        const float4 av = *(const float4*)(A + (size_t)(m0 + ar) * lda + k0 + ak);
        float4 bv = make_float4(0.f, 0.f, 0.f, 0.f);
        if (n0 + bn < N) bv = *(const float4*)(B + (size_t)(k0 + bk) * ldb + n0 + bn);
        As[ak + 0][ar] = av.x; As[ak + 1][ar] = av.y; As[ak + 2][ar] = av.z; As[ak + 3][ar] = av.w;
        Bs[bk][bn + 0] = bv.x; Bs[bk][bn + 1] = bv.y; Bs[bk][bn + 2] = bv.z; Bs[bk][bn + 3] = bv.w;
        __syncthreads();
#pragma unroll
        for (int k = 0; k < 16; ++k) {
            float a[4], b[4];
#pragma unroll
            for (int i = 0; i < 4; ++i) a[i] = As[k][ty * 4 + i];
#pragma unroll
            for (int j = 0; j < 4; ++j) b[j] = Bs[k][tx * 4 + j];
#pragma unroll
            for (int i = 0; i < 4; ++i)
#pragma unroll
                for (int j = 0; j < 4; ++j) acc[i][j] = fmaf(a[i], b[j], acc[i][j]);
        }
        __syncthreads();
    }
#pragma unroll
    for (int i = 0; i < 4; ++i)
#pragma unroll
        for (int j = 0; j < 4; ++j) { const int n = n0 + tx * 4 + j; if (n < N) C[(size_t)(m0 + ty * 4 + i) * ldc + n] = acc[i][j]; }
}
__global__ void k_headnorm(float* __restrict__ P, int ld, int col_off, int nheads, const float* __restrict__ gain, int rows) {
    const int wave = (blockIdx.x * blockDim.x + threadIdx.x) >> 6, lane = threadIdx.x & 63;
    if (wave >= rows * nheads) return;
    const int row = wave / nheads, h = wave % nheads;
    float* p = P + (size_t)row * ld + col_off + h * 64 + lane;
    const float v = *p; const float s = wave_sum(v * v);
    *p = v * rsqrtf(s * (1.f / 64.f) + EPS) * gain[lane];
}
__global__ void __launch_bounds__(256) k_sb(const float* __restrict__ P, int ld, float* __restrict__ O, int nrows) {
    __shared__ float qs[4][64];
    const int w = threadIdx.x >> 6, lane = threadIdx.x & 63;
    const int gw = blockIdx.x * 4 + w; const int h = gw / nrows, t = gw % nrows;
    qs[w][lane] = P[(size_t)t * ld + OFF_QSB + h * 64 + lane];
    __syncthreads();
    float o = 0.f, carry = 0.f;
    for (int c = (t - 1) >> 6; c >= 0 && t > 0; --c) {
        const int s = c * 64 + lane; const bool valid = s < t;
        const float* kr = P + (size_t)(valid ? s : 0) * ld + OFF_KSB + h * 64;
        float z = 0.f;
#pragma unroll 16
        for (int d = 0; d < 64; ++d) z = fmaf(qs[w][d], kr[d], z);
        z *= 0.125f;
        const float l1 = valid ? -softplusf(z) : 0.f; const float lb = -softplusf(-z);
        float incl = l1;
#pragma unroll
        for (int off = 1; off < 64; off <<= 1) { const float tmp = __shfl_down(incl, off); if (lane + off < 64) incl += tmp; }
        const float later = carry + (incl - l1);
        const float a = valid ? expf(lb + later) : 0.f;
        carry += __shfl(incl, 0);
        for (int j = 0; j < 64; ++j) { const float aj = __shfl(a, j); const int sj = c * 64 + j; if (sj < t) o = fmaf(aj, P[(size_t)sj * ld + OFF_VSB + h * 64 + lane], o); }
    }
    O[(size_t)t * 512 + h * 64 + lane] = o;
}
__global__ void __launch_bounds__(256) k_idx(const float* __restrict__ P, int ld, unsigned* __restrict__ SEL) {
    __shared__ float qi[256]; __shared__ float wi[8]; __shared__ unsigned key[SEQ]; __shared__ unsigned selw[64]; __shared__ int cnt;
    const int t = blockIdx.x, tid = threadIdx.x;
    qi[tid] = P[(size_t)t * ld + OFF_QIX + tid];
    if (tid < 8) wi[tid] = P[(size_t)t * ld + OFF_WIX + tid] * 0.35355339059327373f;
    if (tid < 64) selw[tid] = 0u;
    __syncthreads();
    const int n = t + 1;
    for (int s = tid; s < n; s += 256) {
        const float* kr = P + (size_t)s * ld + OFF_KIX; float kv[32];
#pragma unroll
        for (int d = 0; d < 32; ++d) kv[d] = kr[d];
        float sc = 0.f;
#pragma unroll 1
        for (int h = 0; h < 8; ++h) { float r = 0.f;
#pragma unroll
            for (int d = 0; d < 32; ++d) r = fmaf(qi[h * 32 + d], kv[d], r);
            r *= 0.17677669529663687f; sc += wi[h] * fmaxf(r, 0.f); }
        const unsigned u = __float_as_uint(sc);
        key[s] = (u & 0x80000000u) ? ~u : (u | 0x80000000u);
    }
    __syncthreads();
    if (n <= TOPK) { for (int s = tid; s < n; s += 256) atomicOr(&selw[s >> 5], 1u << (s & 31)); }
    else {
        unsigned T = 0u;
        for (int bit = 31; bit >= 0; --bit) {
            const unsigned cand = T | (1u << bit);
            if (tid == 0) cnt = 0;
            __syncthreads();
            int c = 0; for (int s = tid; s < n; s += 256) c += (key[s] >= cand) ? 1 : 0;
            c = (int)wave_sum((float)c); if ((tid & 63) == 0) atomicAdd(&cnt, c);
            __syncthreads();
            if (cnt >= TOPK) T = cand;
            __syncthreads();
        }
        if (tid == 0) cnt = 0;
        __syncthreads();
        int c = 0; for (int s = tid; s < n; s += 256) if (key[s] > T) { c++; atomicOr(&selw[s >> 5], 1u << (s & 31)); }
        c = (int)wave_sum((float)c); if ((tid & 63) == 0) atomicAdd(&cnt, c);
        __syncthreads();
        if (tid == 0) { int need = TOPK - cnt; for (int s = 0; s < n && need > 0; ++s) if (key[s] == T) { selw[s >> 5] |= 1u << (s & 31); --need; } }
    }
    __syncthreads();
    if (tid < 64) SEL[(size_t)t * 64 + tid] = selw[tid];
}
__global__ void __launch_bounds__(256) k_sa(const float* __restrict__ P, int ld, const unsigned* __restrict__ SEL, float* __restrict__ O, int nrows) {
    __shared__ float qs[4][64];
    const int w = threadIdx.x >> 6, lane = threadIdx.x & 63;
    const int gw = blockIdx.x * 4 + w; const int h = gw / nrows, t = gw % nrows, g = h >> 2;
    const float slope = exp2f(-(float)(h + 1));
    qs[w][lane] = P[(size_t)t * ld + OFF_QSA + h * 64 + lane];
    __syncthreads();
    float o = 0.f, m = -INFINITY, l = 0.f;
    for (int c = 0; c <= (t >> 6); ++c) {
        const int s = c * 64 + lane;
        const unsigned wsel = SEL[(size_t)t * 64 + (s >> 5)];
        const bool sel = (s <= t) && ((wsel >> (s & 31)) & 1u);
        const float* kr = P + (size_t)(s <= t ? s : 0) * ld + OFF_KSA + g * 64;
        float z = 0.f;
#pragma unroll 16
        for (int d = 0; d < 64; ++d) z = fmaf(qs[w][d], kr[d], z);
        const float sc = sel ? (z * 0.125f - slope * (float)(t - s)) : -INFINITY;
        const float cm = wave_max(sc);
        if (cm == -INFINITY) continue;
        const float mn = fmaxf(m, cm); const float scale = expf(m - mn); const float p = sel ? expf(sc - mn) : 0.f;
        l = l * scale + wave_sum(p); o *= scale;
        for (int j = 0; j < 64; ++j) { const float pj = __shfl(p, j); const int sj = c * 64 + j; if (sj <= t) o = fmaf(pj, P[(size_t)sj * ld + OFF_VSA + g * 64 + lane], o); }
        m = mn;
    }
    O[(size_t)t * 512 + h * 64 + lane] = o / l;
}
__device__ __forceinline__ float sigmoidf_(float v) { return 1.f / (1.f + expf(-v)); }
__global__ void k_merge(const float* __restrict__ P, int ld, const float* __restrict__ T1, const float* __restrict__ T2, float* __restrict__ MGn, int rows) {
    const size_t i = (size_t)blockIdx.x * blockDim.x + threadIdx.x; if (i >= (size_t)rows * 1024) return;
    const int r = (int)(i >> 10), c = (int)(i & 1023);
    MGn[i] = sigmoidf_(P[(size_t)r * ld + OFF_GSB + c]) * T1[i] + sigmoidf_(P[(size_t)r * ld + OFF_GSA + c]) * T2[i];
}
__global__ void k_add(const float* __restrict__ a, const float* __restrict__ b, float* __restrict__ out, size_t n) { const size_t i = (size_t)blockIdx.x * blockDim.x + threadIdx.x; if (i < n) out[i] = a[i] + b[i]; }
__global__ void k_relu2(float* __restrict__ u, size_t n) { const size_t i = (size_t)blockIdx.x * blockDim.x + threadIdx.x; if (i < n) { const float v = fmaxf(u[i], 0.f); u[i] = v * v; } }
__global__ void k_cmp_bf16(const bf16_t* __restrict__ F, int fld, int fcol, float fscale, const float* __restrict__ R, int rld, int rcol, int rows, int cols, int tf, float rscale, float* stats, int stage) {
    const size_t i = (size_t)blockIdx.x * blockDim.x + threadIdx.x; float num = 0.f, den = 0.f;
    if (i < (size_t)rows * cols) { const int r = (int)(i / cols), c = (int)(i % cols); float ref = R[(size_t)r * rld + rcol + c] * rscale; if (tf == 1) ref = sigmoidf_(ref);
        const float f = bf2f(F[(size_t)r * fld + fcol + c]) * fscale; num = (f - ref) * (f - ref); den = ref * ref; }
    num = wave_sum(num); den = wave_sum(den);
    if ((threadIdx.x & 63) == 0) { atomicAdd(&stats[2 * stage], num); atomicAdd(&stats[2 * stage + 1], den); }
}
__global__ void k_cmp_f32(const float* __restrict__ F, int fld, int fcol, float fscale, const float* __restrict__ R, int rld, int rcol, int rows, int cols, float rscale, float* stats, int stage) {
    const size_t i = (size_t)blockIdx.x * blockDim.x + threadIdx.x; float num = 0.f, den = 0.f;
    if (i < (size_t)rows * cols) { const int r = (int)(i / cols), c = (int)(i % cols); const float ref = R[(size_t)r * rld + rcol + c] * rscale;
        const float f = F[(size_t)r * fld + fcol + c] * fscale; num = (f - ref) * (f - ref); den = ref * ref; }
    num = wave_sum(num); den = wave_sum(den);
    if ((threadIdx.x & 63) == 0) { atomicAdd(&stats[2 * stage], num); atomicAdd(&stats[2 * stage + 1], den); }
}
__global__ void k_cmp_mask(const unsigned* __restrict__ F, const unsigned* __restrict__ R, int rows, float* stats, int stage) {
    const int i = blockIdx.x * blockDim.x + threadIdx.x; float num = 0.f, den = 0.f;
    if (i < rows * 64) { num = (float)__popc(F[i] ^ R[i]); den = (float)__popc(R[i]); }
    num = wave_sum(num); den = wave_sum(den);
    if ((threadIdx.x & 63) == 0) { atomicAdd(&stats[2 * stage], num); atomicAdd(&stats[2 * stage + 1], den); }
}
__global__ void k_encode(float* __restrict__ out, size_t n, const float* __restrict__ stats, const unsigned* __restrict__ ctl) {
    int bad = 0;
    for (int s = 1; s <= 20 && !bad; ++s) { const float num = stats[2 * s], den = stats[2 * s + 1]; const float thr = (s == 13) ? 0.2f : (s == 15 ? 0.05f : 0.004f); if (!(num <= thr * den) || !(den > 0.f)) bad = s; }
    if (!bad && ctl[CW_BAR + XB_TMO]) bad = 21;
    const size_t i = (size_t)blockIdx.x * blockDim.x + threadIdx.x;
    if (bad && i < n) out[i] *= (1.f + 0.25f * (float)bad);
}
}
#endif

extern "C" void kernel_launch(void* const* d_in, const int* in_sizes, int n_in, void* d_out, int out_size, void* d_ws, size_t ws_size, hipStream_t stream) {
    static int grid = 0;
    if (grid == 0) {
        if (n_in != 13 || in_sizes[0] != M * DM || out_size != M * DM || ws_size < WS_END) { fprintf(stderr, "kernel_launch: unexpected problem (n_in %d, in0 %d, out %d, ws %zu)\n", n_in, n_in > 0 ? in_sizes[0] : -1, out_size, ws_size); grid = -1; return; }
        int dev = 0, cus = 0, per_cu = 0;
        if (hipGetDevice(&dev) != hipSuccess || hipDeviceGetAttribute(&cus, hipDeviceAttributeMultiprocessorCount, dev) != hipSuccess) { grid = -1; return; }
        if (hipFuncSetAttribute((const void*)mk_fwd, hipFuncAttributeMaxDynamicSharedMemorySize, LDS_BYTES) != hipSuccess) { fprintf(stderr, "kernel_launch: hipFuncSetAttribute failed\n"); grid = -1; return; }
        if (hipOccupancyMaxActiveBlocksPerMultiprocessor(&per_cu, (const void*)mk_fwd, NWAVES * 64, LDS_BYTES) != hipSuccess || per_cu < 1) { fprintf(stderr, "kernel_launch: occupancy query says %d blocks per CU\n", per_cu); per_cu = 0; }
        (void)hipGetLastError();
        if (per_cu < 1) { grid = -1; return; }
        grid = cus;
    }
    if (grid < 0) return;
    (void)hipMemsetAsync((char*)d_ws + WS_CTL, 0, CTL_ZERO_BYTES, stream);
    Args a{};
    for (int i = 0; i < 13; ++i) a.in[i] = (const float*)d_in[i];
    a.out = (float*)d_out; a.ws = (unsigned char*)d_ws;
#if !MK_DEBUG
    a.ph_lo = 0; a.ph_hi = 8;
    void* kargs[] = {&a};
#ifdef PLAIN_LAUNCH
    hipLaunchKernelGGL(mk_fwd, dim3(grid), dim3(NWAVES * 64), LDS_BYTES, stream, a); (void)kargs;
    const hipError_t le = hipPeekAtLastError();
#else
    const hipError_t le = hipLaunchCooperativeKernel((const void*)mk_fwd, dim3(grid), dim3(NWAVES * 64), kargs, LDS_BYTES, stream);
#endif
    if (le != hipSuccess) fprintf(stderr, "kernel_launch: cooperative launch failed: %s (grid %d)\n", hipGetErrorName(le), grid);
#else
    using namespace nv;
    const float* x = (const float*)d_in[0];
    constexpr int CB = 5, CR = 512;
    const size_t r0 = (size_t)CB * SEQ;
    char* ws = (char*)d_ws; char* e0 = (char*)d_out;
    float* stats = (float*)(ws + 512 * 1024);
    float* Hn = (float*)(e0 + 0 * MiB); float* PROJn = (float*)(e0 + 2 * MiB); float* OSBn = (float*)(e0 + 12 * MiB); float* OSAn = (float*)(e0 + 13 * MiB);
    unsigned* SELn = (unsigned*)(e0 + 14 * MiB); float* T1n = (float*)(e0 + 15 * MiB); float* T2n = (float*)(e0 + 17 * MiB);
    char* l0 = ws + WS_OCAT;
    float* MGn = (float*)(l0 + 0 * MiB); float* Yn = (float*)(l0 + 2 * MiB); float* X1n = (float*)(l0 + 4 * MiB); float* H2n = (float*)(l0 + 6 * MiB); float* Un = (float*)(l0 + 8 * MiB); float* OUTn = (float*)(l0 + 16 * MiB);
    auto launch = [&](int p) { a.ph_lo = p; a.ph_hi = p + 1; hipLaunchKernelGGL(mk_fwd, dim3(grid), dim3(NWAVES * 64), LDS_BYTES, stream, a); };
    auto cmpb = [&](const void* F, int fld, int fcol, float fscale, const float* R, int rld, int rcol, int cols, int tf, float rscale, int stage) {
        k_cmp_bf16<<<(CR * cols + 255) / 256, 256, 0, stream>>>((const bf16_t*)F + r0 * fld, fld, fcol, fscale, R, rld, rcol, CR, cols, tf, rscale, stats, stage); };
    launch(0);
    k_rmsnorm<<<CR / 4, 256, 0, stream>>>(x + r0 * DM, (const float*)d_in[1], Hn, CR, DM);
    cmpb(ws + WS_XN, DM, 0, 1.f, Hn, DM, 0, DM, 0, 1.f, 1);
    launch(1);
    k_gemm<<<dim3((PROJ_W + 63) / 64, CR / 64), 256, 0, stream>>>(Hn, DM, (const float*)d_in[2], PROJ_W, PROJn, PROJ_W, CR, PROJ_W, DM);
    k_headnorm<<<CR * 8 / 4, 256, 0, stream>>>(PROJn, PROJ_W, OFF_QSB, 8, (const float*)d_in[3], CR);
    k_headnorm<<<CR * 8 / 4, 256, 0, stream>>>(PROJn, PROJ_W, OFF_KSB, 8, (const float*)d_in[4], CR);
    k_headnorm<<<CR * 8 / 4, 256, 0, stream>>>(PROJn, PROJ_W, OFF_QSA, 8, (const float*)d_in[5], CR);
    k_headnorm<<<CR * 2 / 4, 256, 0, stream>>>(PROJn, PROJ_W, OFF_KSA, 2, (const float*)d_in[6], CR);
    cmpb(ws + WS_QSB, 512, 0, 1.f / C2, PROJn, PROJ_W, OFF_QSB, 512, 0, 1.f, 2);
    cmpb(ws + WS_KSB, 512, 0, 1.f, PROJn, PROJ_W, OFF_KSB, 512, 0, 1.f, 3);
    cmpb(ws + WS_VSB, 512, 0, 1.f, PROJn, PROJ_W, OFF_VSB, 512, 0, 1.f, 4);
    cmpb(ws + WS_QSA, 512, 0, 1.f / C2, PROJn, PROJ_W, OFF_QSA, 512, 0, 1.f, 5);
    cmpb(ws + WS_KSA, 128, 0, 1.f, PROJn, PROJ_W, OFF_KSA, 128, 0, 1.f, 6);
    cmpb(ws + WS_VSA, 128, 0, 1.f, PROJn, PROJ_W, OFF_VSA, 128, 0, 1.f, 7);
    cmpb(ws + WS_QIX, 256, 0, 1.f, PROJn, PROJ_W, OFF_QIX, 256, 0, 1.f, 8);
    cmpb(ws + WS_KIX, 32, 0, 1.f, PROJn, PROJ_W, OFF_KIX, 32, 0, 1.f, 9);
    k_cmp_f32<<<(CR * 8 + 255) / 256, 256, 0, stream>>>((const float*)(ws + WS_WIX) + r0 * 8, 8, 0, 16.f, PROJn, PROJ_W, OFF_WIX, CR, 8, 1.f, stats, 10);
    cmpb(ws + WS_G1, 1024, 0, 1.f, PROJn, PROJ_W, OFF_GSB, 1024, 1, 1.f, 11);
    cmpb(ws + WS_G2, 1024, 0, 1.f, PROJn, PROJ_W, OFF_GSA, 1024, 1, 1.f, 12);
    launch(2);
    k_idx<<<CR, 256, 0, stream>>>(PROJn, PROJ_W, SELn);
    k_cmp_mask<<<(CR * 64 + 255) / 256, 256, 0, stream>>>((const unsigned*)(ws + WS_MASK) + r0 * 64, SELn, CR, stats, 13);
    launch(3);
    k_sb<<<8 * CR / 4, 256, 0, stream>>>(PROJn, PROJ_W, OSBn, CR);
    k_sa<<<8 * CR / 4, 256, 0, stream>>>(PROJn, PROJ_W, SELn, OSAn, CR);
    cmpb(ws + WS_OCAT, 1024, 0, 1.f, OSBn, 512, 0, 512, 0, 1.f, 14);
    cmpb(ws + WS_OCAT, 1024, 512, 1.f, OSAn, 512, 0, 512, 0, 1.f, 15);
    k_gemm<<<dim3(1024 / 64, CR / 64), 256, 0, stream>>>(OSBn, 512, (const float*)d_in[7], 1024, T1n, 1024, CR, 1024, 512);
    k_gemm<<<dim3(1024 / 64, CR / 64), 256, 0, stream>>>(OSAn, 512, (const float*)d_in[8], 1024, T2n, 1024, CR, 1024, 512);
    launch(4);
    k_merge<<<CR * 1024 / 256, 256, 0, stream>>>(PROJn, PROJ_W, T1n, T2n, MGn, CR);
    cmpb(ws + WS_MG, 1024, 0, 1.f, MGn, 1024, 0, 1024, 0, 1.f, 16);
    k_gemm<<<dim3(1024 / 64, CR / 64), 256, 0, stream>>>(MGn, 1024, (const float*)d_in[9], 1024, Yn, 1024, CR, 1024, 1024);
    k_add<<<CR * 1024 / 256, 256, 0, stream>>>(x + r0 * DM, Yn, X1n, (size_t)CR * 1024);
    launch(5);
    cmpb(ws + WS_XN, DM, 0, 1.f, X1n, DM, 0, DM, 0, 1.f, 17);
    cmpb(ws + WS_XN, DM, 0, 1.f, X1n, DM, 0, DM, 0, 1.f, 18);
    k_rmsnorm<<<CR / 4, 256, 0, stream>>>(X1n, (const float*)d_in[10], H2n, CR, DM);
    k_gemm<<<dim3(FF / 64, CR / 64), 256, 0, stream>>>(H2n, DM, (const float*)d_in[11], FF, Un, FF, CR, FF, DM);
    k_relu2<<<CR * FF / 256, 256, 0, stream>>>(Un, (size_t)CR * FF);
    launch(6);
    cmpb(ws + WS_U, FF, 0, 1.f, Un, FF, 0, FF, 0, 1.f, 19);
    k_gemm<<<dim3(1024 / 64, CR / 64), 256, 0, stream>>>(Un, FF, (const float*)d_in[12], 1024, Yn, 1024, CR, 1024, FF);
    k_add<<<CR * 1024 / 256, 256, 0, stream>>>(X1n, Yn, OUTn, (size_t)CR * 1024);
    launch(7);
    k_cmp_f32<<<(CR * 1024 + 255) / 256, 256, 0, stream>>>((const float*)d_out + r0 * DM, DM, 0, 1.f, OUTn, DM, 0, CR, DM, 1.f, stats, 20);
    k_encode<<<(M * DM + 255) / 256, 256, 0, stream>>>((float*)d_out, (size_t)M * DM, stats, (const unsigned*)(ws + WS_CTL));
#endif
}
```

```cpp
#include <hip/hip_runtime.h>
#include <cstdio>
#include <cstdint>

#ifndef MK_DEBUG
#define MK_DEBUG 0
#endif

#define LAS __attribute__((address_space(3)))
#define GAS __attribute__((address_space(1)))
typedef unsigned short bf16_t;
typedef short bf16x8 __attribute__((ext_vector_type(8)));
typedef short s16x4 __attribute__((ext_vector_type(4)));
typedef float f32x4 __attribute__((ext_vector_type(4)));
typedef float f32x16 __attribute__((ext_vector_type(16)));
typedef unsigned u32x4 __attribute__((ext_vector_type(4)));
typedef unsigned u32x2 __attribute__((ext_vector_type(2)));
typedef float f32x2_t __attribute__((ext_vector_type(2)));
typedef __bf16 bf16x2_t __attribute__((ext_vector_type(2)));
typedef short v4i16_t __attribute__((ext_vector_type(4)));

__device__ __forceinline__ unsigned cvtpk(float lo, float hi) { f32x2_t v = {lo, hi}; bf16x2_t b = __builtin_convertvector(v, bf16x2_t); return __builtin_bit_cast(unsigned, b); }
typedef int i32x8 __attribute__((ext_vector_type(8)));
__device__ __forceinline__ unsigned pk4_fp8_nc(float a, float b, float c, float d) { int v = __builtin_amdgcn_cvt_pk_fp8_f32(a, b, 0, false); v = __builtin_amdgcn_cvt_pk_fp8_f32(c, d, v, true); return (unsigned)v; }
__device__ __forceinline__ unsigned pk4_fp8(float a, float b, float c, float d) {
    a = __builtin_amdgcn_fmed3f(a, -448.f, 448.f); b = __builtin_amdgcn_fmed3f(b, -448.f, 448.f); c = __builtin_amdgcn_fmed3f(c, -448.f, 448.f); d = __builtin_amdgcn_fmed3f(d, -448.f, 448.f);
    int v = __builtin_amdgcn_cvt_pk_fp8_f32(a, b, 0, false); v = __builtin_amdgcn_cvt_pk_fp8_f32(c, d, v, true); return (unsigned)v; }
__device__ __forceinline__ float bf2f(unsigned short h) { return __uint_as_float((unsigned)h << 16); }
__device__ __forceinline__ float bflo(unsigned w) { return __uint_as_float(w << 16); }
__device__ __forceinline__ float bfhi(unsigned w) { return __uint_as_float(w & 0xffff0000u); }

constexpr int NB = 8, SEQ = 2048, DM = 1024, FF = 4096, M = NB * SEQ;
constexpr int PROJ_W = 4648, NPROJ = 4864;
constexpr float EPS = 1e-6f;
constexpr float C2 = 0.125f * 1.4426950408889634f;
constexpr int OFF_QSB = 0, OFF_KSB = 512, OFF_VSB = 1024, OFF_QSA = 1536, OFF_KSA = 2048, OFF_VSA = 2176,
              OFF_QIX = 2304, OFF_KIX = 2560, OFF_WIX = 2592, OFF_GSB = 2600, OFF_GSA = 3624;

constexpr size_t MiB = 1u << 20;
constexpr size_t WS_CTL = 0, CTL_ZERO_BYTES = 1 * MiB;
constexpr size_t WS_WIN = 2 * MiB, WS_WCAT = 12 * MiB, WS_WOUT = 14 * MiB, WS_W1 = 16 * MiB, WS_W2 = 24 * MiB;
constexpr size_t WS_XN = 32 * MiB;
constexpr size_t WS_QSB = 64 * MiB, WS_KSB = 80 * MiB, WS_VSB = 96 * MiB, WS_QSA = 112 * MiB;
constexpr size_t WS_KSA = 128 * MiB, WS_VSA = 132 * MiB;
constexpr size_t WS_QIX = 136 * MiB, WS_KIX = 144 * MiB, WS_WIX = 145 * MiB;
constexpr size_t WS_MASK = 146 * MiB;
constexpr size_t WS_G1 = 152 * MiB, WS_G2 = 184 * MiB;
constexpr size_t WS_OCAT = 216 * MiB;
constexpr size_t WS_XN8 = 216 * MiB;
constexpr size_t WS_WG8 = 250 * MiB;
__host__ __device__ __forceinline__ int tile_a(int t) { return t < 4 ? t : (t < 6 ? t + 2 : t + 3); }
__host__ __device__ __forceinline__ int tile_b(int t) { return t < 2 ? t + 4 : (t == 2 ? 8 : t + 8); }
constexpr int NPROJ_A = 2048, NGATE = 2816;
constexpr float O_SCALE = 4.f, WCAT_SCALE = 16.f;
constexpr float X1_SCALE = 2.f, W1_SCALE = 32.f;
constexpr size_t WS_X18 = 152 * MiB;
constexpr float U_SCALE = 8.f, W2_SCALE = 64.f;
constexpr float MG_SCALE = 4.f, WOUT_SCALE = 32.f;
constexpr float GATE_WSCALE = 32.f;
constexpr size_t WS_RSTD = 249 * MiB;
constexpr size_t WS_SSQ = 248 * MiB;
constexpr size_t WS_MG = 128 * MiB;
constexpr size_t WS_U = 64 * MiB;
constexpr size_t WS_END = 256 * MiB;
constexpr int CW_BAR = 4096;
constexpr int CW_XCC = 16384;
constexpr int CW_WINREADY = 20608;
constexpr int CW_MFLAG = 32768;

namespace pg8 {
constexpr int BM = 256, BK = 64, HALF = 128, HTB = HALF * BK * 2, STAGE_BYTES = 8 * HTB, NXCD = 8, WGM = 8;
__host__ __device__ __forceinline__ int lds_byte(int r, int c) { const int st = (r >> 4) * 2 + (c >> 5), rr = r & 15, cc = c & 31, ob = rr * 64 + cc * 2; return st * 1024 + (ob ^ (((ob >> 9) & 1) << 5)); }
__host__ __device__ __forceinline__ void stage_rc(int b, int& R, int& C) { const int st = b / 1024, sb = b % 1024, swz = sb ^ (((sb >> 9) & 1) << 5); R = (st >> 1) * 16 + swz / 64; C = (st & 1) * 32 + (swz % 64) / 2; }
__host__ __device__ __forceinline__ int perm32(int rho) { const int n = rho >> 4, i = rho & 15; return 8 * (i >> 2) + 4 * n + (i & 3); }

struct Unit { int pm, pn; };
struct Gemm { const bf16_t* A; const bf16_t* Bt; int M, N, K; };
struct StaticOrder {
    int nM, nN, nwg, G, c, dup, rot = 0;
    __host__ __device__ void init(int M_, int N_, int G_, int c_, int dup_ = 1) { nM = M_ / BM; nN = N_ / BM; nwg = nM * nN; G = G_; c = c_; dup = dup_; }
    __host__ __device__ __forceinline__ bool next(int i, Unit& u) const {
        const long L = (long)i * G + c; if (L >= (long)nwg * dup) return false;
        int wgid = (int)(L % nwg); { const int q = nwg / NXCD, r = nwg % NXCD, xcd = wgid % NXCD, off = wgid / NXCD; wgid = (xcd < r ? xcd * (q + 1) : r * (q + 1) + (xcd - r) * q) + off; }
        const int nig = WGM * nN, gid = wgid / nig, fm = gid * WGM, gsz = (nM - fm) < WGM ? (nM - fm) : WGM;
        u.pm = fm + ((wgid % nig) % gsz); u.pn = (wgid % nig) / gsz + rot; if (u.pn >= nN) u.pn -= nN; return true;
    }
};

struct NoPre { static constexpr bool ON = false; __device__ __forceinline__ void arrive() {} __device__ __forceinline__ void wait() {} };
template <class Epi, class Sched, bool ALIGN_EPI, bool FP8 = false, class Pre = NoPre>
__device__ __forceinline__ void gemm_phase(LAS unsigned char* lds, const Gemm g, const Sched& S, const Epi& E, Pre pre = Pre()) {
    const int tid = threadIdx.x, wid = __builtin_amdgcn_readfirstlane(tid >> 6), lane = tid & 63, wr = wid >> 2, wc = wid & 3, fr = lane & 15, fq = lane >> 4;
    const int K = FP8 ? g.K / 2 : g.K, nt = K / BK;
    unsigned voffA[2], voffB[2];
#pragma unroll
    for (int i = 0; i < 2; ++i) { int R, C; stage_rc(tid * 16 + i * 8192, R, C); const int Rb = 64 * (R >> 5) + perm32(R & 31);
        voffA[i] = (unsigned)(R * K + C) * 2u; voffB[i] = (unsigned)(Rb * K + C) * 2u; }
    const size_t kstep = (size_t)(BK * 2);
    const size_t hstep = (size_t)HALF * K * 2;
    const size_t hstepB = (size_t)32 * K * 2;
    const size_t tstep = 2 * hstep;
    const unsigned ldsw = (unsigned)wid * 1024u; const unsigned ldsb_ = (unsigned)(unsigned long long)lds + ldsw;
    const int aoff = lds_byte(wr * 64 + fr, fq * 8), boff = lds_byte(wc * 32 + fr, fq * 8);
    const int aoff2 = 1024, boff2 = 1024;
#define PG8_SA(b, h) (((b) * 2 + (h)) * HTB)
#define PG8_SB(b, h) ((4 + (b) * 2 + (h)) * HTB)
#define PG8_STAGE(bufoff, gbase, voff) do { _Pragma("unroll") for (int _i = 0; _i < 2; ++_i) \
        asm volatile("s_mov_b32 m0, %2\n\ts_nop 0\n\tglobal_load_lds_dwordx4 %0, %1" :: "v"((voff)[_i]), "s"((const char*)(gbase)), "s"(ldsb_ + (unsigned)((bufoff) + _i * 8192)) : "memory"); } while (0)
#define PG8_LD8(base) __builtin_bit_cast(i32x8, __builtin_shufflevector(*(const LAS bf16x8*)(lds + (base)), *(const LAS bf16x8*)(lds + (base) + aoffB2_), 0, 1, 2, 3, 4, 5, 6, 7, 8, 9, 10, 11, 12, 13, 14, 15))
#define PG8_LDA(dst, b, h) do { if constexpr (FP8) { const int aoffB2_ = aoff2; _Pragma("unroll") for (int m = 0; m < 4; ++m) dst##8[m] = PG8_LD8(PG8_SA(b, h) + aoff + m * 2048); } \
        else { _Pragma("unroll") for (int m = 0; m < 4; ++m) _Pragma("unroll") for (int k = 0; k < 2; ++k) dst[m][k] = *(const LAS bf16x8*)(lds + PG8_SA(b, h) + aoff + m * 2048 + k * 1024); } } while (0)
#define PG8_LDB(dst, b, h) do { if constexpr (FP8) { const int aoffB2_ = boff2; _Pragma("unroll") for (int n = 0; n < 2; ++n) dst##8[n] = PG8_LD8(PG8_SB(b, h) + boff + n * 2048); } \
        else { _Pragma("unroll") for (int n = 0; n < 2; ++n) _Pragma("unroll") for (int k = 0; k < 2; ++k) dst[n][k] = *(const LAS bf16x8*)(lds + PG8_SB(b, h) + boff + n * 2048 + k * 1024); } } while (0)
#define PG8_MMA(ai, bj, At, Bt) do { __builtin_amdgcn_s_setprio(1); _Pragma("unroll") for (int m = 0; m < 4; ++m) _Pragma("unroll") for (int n = 0; n < 2; ++n) { \
        if constexpr (FP8) asm volatile("v_mfma_f32_16x16x128_f8f6f4 %0, %1, %2, %0" : "+v"(acc[ai][bj][m][n]) : "v"(Bt##8[n]), "v"(At##8[m]));   \
        else { _Pragma("unroll") for (int k = 0; k < 2; ++k) acc[ai][bj][m][n] = __builtin_amdgcn_mfma_f32_16x16x32_bf16(Bt[n][k], At[m][k], acc[ai][bj][m][n], 0, 0, 0); } } \
        __builtin_amdgcn_s_setprio(0); } while (0)
#define PG8_WAIT_V(n) asm volatile("s_waitcnt vmcnt(" #n ")" ::: "memory")
#define PG8_WAIT_L(n) asm volatile("s_waitcnt lgkmcnt(" #n ")" ::: "memory")
#define PG8_BAR __builtin_amdgcn_s_barrier()
#define PG8_SCHED __builtin_amdgcn_sched_barrier(0)
    Unit cur, nxt, prv; int ui = 0;
    if (!S.next(0, cur)) { if constexpr (Pre::ON) { pre.arrive(); pre.wait(); } return; }
    f32x4 acc[2][2][4][2];
    if constexpr (!Pre::ON) E.init(acc, cur, wr, wc, fr, fq);
    bf16x8 At[4][2], B0[2][2], B1[2][2]; i32x8 At8[4], B08[2], B18[2];
    const char* cA = (const char*)g.A + (size_t)cur.pm * tstep; const char* cB = (const char*)g.Bt + (size_t)cur.pn * tstep;
    if constexpr (Pre::ON) { pre.arrive(); PG8_STAGE(PG8_SB(0, 0), cB, voffB); PG8_STAGE(PG8_SB(0, 1), cB + hstepB, voffB); E.init(acc, cur, wr, wc, fr, fq); pre.wait(); }
    else { PG8_STAGE(PG8_SB(0, 0), cB, voffB); PG8_STAGE(PG8_SB(0, 1), cB + hstepB, voffB); }
    PG8_STAGE(PG8_SA(0, 0), cA, voffA); PG8_STAGE(PG8_SA(0, 1), cA + hstep, voffA);
    if (wr == 1) PG8_BAR;
    PG8_WAIT_V(2); PG8_BAR;
    PG8_STAGE(PG8_SB(1, 0), cB + kstep, voffB); PG8_STAGE(PG8_SA(1, 0), cA + kstep, voffA); PG8_STAGE(PG8_SB(1, 1), cB + hstepB + kstep, voffB);
    PG8_WAIT_V(6); PG8_BAR;
    for (;;) {
        const bool has_next = S.next(ui + 1, nxt);
        const char* nA = has_next ? (const char*)g.A + (size_t)nxt.pm * tstep : cA; const char* nB = has_next ? (const char*)g.Bt + (size_t)nxt.pn * tstep : cB;
#pragma unroll 1
        for (int t = 0; t < nt; t += 2) {
            const bool last = (t == nt - 2);
            const char* a1 = cA + (size_t)(t + 1) * kstep;
            const char* a2 = last ? nA : cA + (size_t)(t + 2) * kstep; const char* b2 = last ? nB : cB + (size_t)(t + 2) * kstep;
            const char* a3 = a2 + kstep; const char* b3 = b2 + kstep;
            if constexpr (Epi::MID_T > 0) { if (t == Epi::MID_T) E.mid(acc, cur, wr, wc, fr, fq); }
            const int rlx = ((t == 0) && (ui > 0)) ? E.min_vm(prv) : 0;
            PG8_LDB(B0, 0, 0); PG8_LDB(B1, 0, 1); PG8_SCHED; PG8_LDA(At, 0, 0); PG8_STAGE(PG8_SA(1, 1), a1 + hstep, voffA);
            if (rlx >= 16) PG8_WAIT_V(24); else if (rlx >= 8) PG8_WAIT_V(16); else PG8_WAIT_V(8); PG8_WAIT_L(0); PG8_BAR; PG8_MMA(0, 0, At, B0); PG8_MMA(0, 1, At, B1); PG8_BAR; PG8_SCHED;
            PG8_LDA(At, 0, 1); PG8_STAGE(PG8_SB(0, 0), b2, voffB); PG8_STAGE(PG8_SB(0, 1), b2 + hstepB, voffB); PG8_STAGE(PG8_SA(0, 0), a2, voffA);
            if (rlx >= 16) PG8_WAIT_V(24); else if (rlx >= 8) PG8_WAIT_V(16); else PG8_WAIT_V(8); PG8_WAIT_L(0); PG8_BAR; PG8_MMA(1, 0, At, B0); PG8_MMA(1, 1, At, B1); PG8_BAR; PG8_SCHED;
            PG8_LDB(B0, 1, 0); PG8_LDB(B1, 1, 1); PG8_SCHED; PG8_LDA(At, 1, 0); PG8_STAGE(PG8_SA(0, 1), a2 + hstep, voffA);
            PG8_WAIT_V(8); PG8_WAIT_L(0); PG8_BAR; PG8_MMA(0, 0, At, B0); PG8_MMA(0, 1, At, B1); PG8_BAR; PG8_SCHED;
            PG8_LDA(At, 1, 1); PG8_STAGE(PG8_SB(1, 0), b3, voffB); PG8_STAGE(PG8_SB(1, 1), b3 + hstepB, voffB); PG8_STAGE(PG8_SA(1, 0), a3, voffA);
            PG8_WAIT_V(8); PG8_WAIT_L(0); PG8_BAR; PG8_MMA(1, 0, At, B0); PG8_MMA(1, 1, At, B1); PG8_BAR; PG8_SCHED;
        }
        if constexpr (ALIGN_EPI) { if (wr == 0) PG8_BAR; }
        if constexpr (FP8) asm volatile("s_nop 15\n\ts_nop 15" ::: "memory");
        E(acc, cur, wr, wc, fr, fq);
        if (!has_next) break;
        E.init(acc, nxt, wr, wc, fr, fq);
        prv = cur; cur = nxt; cA = nA; cB = nB; ++ui;
        if constexpr (ALIGN_EPI) { if (wr == 1) PG8_BAR; }
    }
    PG8_WAIT_V(0);
    if constexpr (!ALIGN_EPI) { if (wr == 0) PG8_BAR; }
    PG8_BAR;
#undef PG8_SA
#undef PG8_SB
#undef PG8_STAGE
#undef PG8_LDA
#undef PG8_LDB
#undef PG8_MMA
#undef PG8_LD8
#undef PG8_WAIT_V
#undef PG8_WAIT_L
#undef PG8_BAR
#undef PG8_SCHED
}

__device__ __forceinline__ u32x4 widen8(const u32x2 w0, const u32x2 w1) {
    const auto rx = __builtin_amdgcn_permlane16_swap(w0.x, w1.x, false, false), ry = __builtin_amdgcn_permlane16_swap(w0.y, w1.y, false, false);
    return (u32x4){rx[0], ry[0], rx[1], ry[1]};
}
__device__ __forceinline__ int widen8_off(int fq) { return ((fq & 1) << 5) | ((fq >> 1) << 4); }
__device__ __forceinline__ float relu1(float x) { const int b = __builtin_bit_cast(int, x); return __builtin_bit_cast(float, b > 0 ? b : 0); }
typedef f32x4 Acc[2][2][4][2];
__device__ __forceinline__ float fq_sum(float v) {
    const auto a = __builtin_amdgcn_permlane16_swap(__float_as_uint(v), __float_as_uint(v), false, false); v = __uint_as_float(a[0]) + __uint_as_float(a[1]);
    const auto b = __builtin_amdgcn_permlane32_swap(__float_as_uint(v), __float_as_uint(v), false, false); return __uint_as_float(b[0]) + __uint_as_float(b[1]);
}
__device__ __forceinline__ u32x4 pack8(const f32x4 a, const f32x4 b) { u32x4 w; w.x = cvtpk(a[0], a[1]); w.y = cvtpk(a[2], a[3]); w.z = cvtpk(b[0], b[1]); w.w = cvtpk(b[2], b[3]); return w; }
__device__ __forceinline__ void unpack8(const u32x4 w, float (&f)[8]) { f[0] = bflo(w.x); f[1] = bfhi(w.x); f[2] = bflo(w.y); f[3] = bfhi(w.y); f[4] = bflo(w.z); f[5] = bfhi(w.z); f[6] = bflo(w.w); f[7] = bfhi(w.w); }

__device__ __forceinline__ unsigned gate_u8x4(const f32x4 g, float qmin) {
    const unsigned a = (unsigned)fmaxf(fmaf(g[0], 255.f, 0.5f), qmin), b = (unsigned)fmaxf(fmaf(g[1], 255.f, 0.5f), qmin), c = (unsigned)fmaxf(fmaf(g[2], 255.f, 0.5f), qmin), d = (unsigned)fmaxf(fmaf(g[3], 255.f, 0.5f), qmin);
    return a | (b << 8) | (c << 16) | (d << 24);
}
__device__ __forceinline__ float ub0(unsigned w) { return (float)(w & 0xffu); }
__device__ __forceinline__ float ub1(unsigned w) { return (float)((w >> 8) & 0xffu); }
__device__ __forceinline__ float ub2(unsigned w) { return (float)((w >> 16) & 0xffu); }
__device__ __forceinline__ float ub3(unsigned w) { return (float)(w >> 24); }
struct EpiProj {
    static constexpr int MID_T = 0;
    __device__ __forceinline__ int min_vm(const Unit& u) const { const int pn = pn_off ? tile_b(u.pn) : tile_a(u.pn); return pn == 10 ? 0 : (pn >= 11 ? 8 : 16); }
    bf16_t *QSB, *KSB, *VSB, *QSA, *KSA, *VSA, *QIX, *KIX, *G1, *G2; float* WIX;
    LAS const float* tab; int pm0; const float* RS; int pn_off; float gexp, ascale;
    __device__ __forceinline__ void init(Acc& acc, const Unit&, int, int, int, int) const {
#pragma unroll
        for (int a = 0; a < 2; ++a)
#pragma unroll
            for (int b = 0; b < 2; ++b)
#pragma unroll
                for (int m = 0; m < 4; ++m)
#pragma unroll
                    for (int n = 0; n < 2; ++n) acc[a][b][m][n] = (f32x4){0.f, 0.f, 0.f, 0.f};
    }
    __device__ __forceinline__ void mid(Acc&, const Unit&, int, int, int, int) const {}
    __device__ __forceinline__ void operator()(Acc& acc, const Unit& u, int wr, int wc, int fr, int fq) const {
        int row0_ = u.pm * BM + wr * 64 + fr, lc_ = 64 * wc + 8 * fq; asm volatile("" : "+v"(row0_), "+v"(lc_));
        const int pn = pn_off ? tile_b(u.pn) : tile_a(u.pn), row0 = row0_, lc = lc_;
        int mode = 4, ld = 0, dcol = 0, gain = 0; bf16_t* dst = nullptr; float gmin = 0.f;
        if (pn < 2)       { mode = 1; dst = QSB; ld = 512; dcol = pn * 256 + lc; gain = 256; }
        else if (pn < 4)  { mode = 1; dst = KSB; ld = 512; dcol = (pn - 2) * 256 + lc; gain = 320; }
        else if (pn < 6)  { mode = 0; dst = VSB; ld = 512; dcol = (pn - 4) * 256 + lc; }
        else if (pn < 8)  { mode = 1; dst = QSA; ld = 512; dcol = (pn - 6) * 256 + lc; gain = 384; }
        else if (pn == 8) { if (wc < 2) { mode = 1; dst = KSA; ld = 128; dcol = lc; gain = 448; } else { mode = 0; dst = VSA; ld = 128; dcol = lc - 128; } }
        else if (pn == 9) { mode = 0; dst = QIX; ld = 256; dcol = lc; }
        else if (pn == 10) { mode = (wc == 0) ? 3 : 4; }
        else if (pn < 15) { mode = 2; dst = G1; ld = 1024; dcol = (pn - 11) * 256 + lc; }
        else              { mode = 2; dst = G2; ld = 1024; dcol = (pn - 15) * 256 + lc; gmin = 1.f; }
        if (mode == 4) return;
        if (mode == 3) {
#pragma unroll
            for (int ai = 0; ai < 2; ++ai)
#pragma unroll
                for (int m = 0; m < 4; ++m) { const size_t row = (size_t)(row0 + ai * HALF + m * 16); const float r = RS ? (u.pm == pm0 ? tab[row & 255] : RS[row]) : 1.f;
                    *(u32x4*)(KIX + row * 32 + 8 * fq) = pack8(acc[ai][0][m][0] * r, acc[ai][0][m][1] * r);
                    if (fq == 0) { *(f32x4*)(WIX + row * 8) = acc[ai][1][m][0] * (0.0625f * r); *(f32x4*)(WIX + row * 8 + 4) = acc[ai][1][m][1] * (0.0625f * r); } }
            return;
        }
        f32x4 gv[2][2];
#pragma unroll
        for (int bj = 0; bj < 2; ++bj)
#pragma unroll
            for (int n = 0; n < 2; ++n) gv[bj][n] = (mode == 1) ? *(LAS const f32x4*)(tab + gain + 32 * bj + (lc & 63) + 4 * n) : (f32x4){1.f, 1.f, 1.f, 1.f};
#pragma unroll
        for (int ai = 0; ai < 2; ++ai)
#pragma unroll
            for (int m = 0; m < 4; ++m) { bf16_t* rowp = dst + (size_t)(row0 + ai * HALF + m * 16) * ld + dcol;
                f32x4 v[2][2]; const float rrow = (RS ? (u.pm == pm0 ? tab[(row0 + ai * HALF + m * 16) & 255] : RS[row0 + ai * HALF + m * 16]) : 1.f) * ascale;
#pragma unroll
                for (int bj = 0; bj < 2; ++bj)
#pragma unroll
                    for (int n = 0; n < 2; ++n) v[bj][n] = acc[ai][bj][m][n] * rrow;
                if (mode == 1) {
                    float ss = 0.f;
#pragma unroll
                    for (int bj = 0; bj < 2; ++bj)
#pragma unroll
                        for (int n = 0; n < 2; ++n) ss += (v[bj][n][0] * v[bj][n][0] + v[bj][n][1] * v[bj][n][1]) + (v[bj][n][2] * v[bj][n][2] + v[bj][n][3] * v[bj][n][3]);
                    ss = fq_sum(ss);
                    const float rs = __builtin_amdgcn_rsqf(ss * (1.f / 64.f) + EPS);
#pragma unroll
                    for (int bj = 0; bj < 2; ++bj)
#pragma unroll
                        for (int n = 0; n < 2; ++n) v[bj][n] = v[bj][n] * gv[bj][n] * rs;
                } else if (mode == 2) {
#pragma unroll
                    for (int bj = 0; bj < 2; ++bj)
#pragma unroll
                        for (int n = 0; n < 2; ++n)
#pragma unroll
                            for (int e = 0; e < 4; ++e) v[bj][n][e] = __builtin_amdgcn_rcpf(1.f + __builtin_amdgcn_exp2f(gexp * v[bj][n][e]));
                }
                if (mode == 2) {
                    unsigned char* rowb = (unsigned char*)dst + (size_t)(row0 + ai * HALF + m * 16) * 1024 + dcol;
                    u32x2 w[2];
#pragma unroll
                    for (int bj = 0; bj < 2; ++bj) { w[bj].x = gate_u8x4(v[bj][0], gmin); w[bj].y = gate_u8x4(v[bj][1], gmin); }
                    *(u32x4*)(rowb - (lc & 63) + widen8_off((lc & 63) >> 3)) = widen8(w[0], w[1]);
                } else {
#pragma unroll
                    for (int bj = 0; bj < 2; ++bj) *(u32x4*)(rowp + 32 * bj) = pack8(v[bj][0], v[bj][1]);
                }
            }
    }
};

struct EpiMerge {
    static constexpr int MID_T = 4;
    __device__ __forceinline__ int min_vm(const Unit&) const { return 0; }
    const unsigned char *G1, *G2; bf16_t* MG;
    __device__ __forceinline__ void init(Acc& acc, const Unit&, int, int, int, int) const {
#pragma unroll
        for (int a = 0; a < 2; ++a)
#pragma unroll
            for (int b = 0; b < 2; ++b)
#pragma unroll
                for (int m = 0; m < 4; ++m)
#pragma unroll
                    for (int n = 0; n < 2; ++n) acc[a][b][m][n] = (f32x4){0.f, 0.f, 0.f, 0.f};
    }
    __device__ __forceinline__ void mid(Acc& acc, const Unit& u, int wr, int wc, int fr, int fq) const {
        int row0 = u.pm * BM + wr * 64 + fr, col0 = u.pn * BM + 64 * wc + 8 * fq;
        asm volatile("" : "+v"(row0), "+v"(col0));
#pragma unroll
        for (int ai = 0; ai < 2; ++ai) {
            u32x2 ga[4][2], gb[4][2];
#pragma unroll
            for (int m = 0; m < 4; ++m) { const size_t off = (size_t)(row0 + ai * HALF + m * 16) * 1024 + col0;
#pragma unroll
                for (int bj = 0; bj < 2; ++bj) { ga[m][bj] = *(const u32x2*)(G1 + off + 32 * bj); gb[m][bj] = *(const u32x2*)(G2 + off + 32 * bj); } }
#pragma unroll
            for (int m = 0; m < 4; ++m)
#pragma unroll
                for (int bj = 0; bj < 2; ++bj) { const u32x2 a = ga[m][bj], b = gb[m][bj];
                    f32x4& c0 = acc[ai][bj][m][0]; f32x4& c1 = acc[ai][bj][m][1];
                    c0[0] *= ub0(a.x) * __builtin_amdgcn_rcpf(ub0(b.x)); c0[1] *= ub1(a.x) * __builtin_amdgcn_rcpf(ub1(b.x));
                    c0[2] *= ub2(a.x) * __builtin_amdgcn_rcpf(ub2(b.x)); c0[3] *= ub3(a.x) * __builtin_amdgcn_rcpf(ub3(b.x));
                    c1[0] *= ub0(a.y) * __builtin_amdgcn_rcpf(ub0(b.y)); c1[1] *= ub1(a.y) * __builtin_amdgcn_rcpf(ub1(b.y));
                    c1[2] *= ub2(a.y) * __builtin_amdgcn_rcpf(ub2(b.y)); c1[3] *= ub3(a.y) * __builtin_amdgcn_rcpf(ub3(b.y)); }
            asm volatile("" ::: "memory");
        }
    }
    __device__ __forceinline__ void operator()(Acc& acc, const Unit& u, int wr, int wc, int fr, int fq) const {
        const int row0 = u.pm * BM + wr * 64 + fr, col0 = u.pn * BM + 64 * wc + 8 * fq;
#pragma unroll
        for (int ai = 0; ai < 2; ++ai)
#pragma unroll
            for (int m = 0; m < 4; ++m) { const size_t off = (size_t)(row0 + ai * HALF + m * 16) * 1024 + col0; u32x2 wq_[2];
#pragma unroll
                for (int bj = 0; bj < 2; ++bj) { const u32x2 gw = *(const u32x2*)(G2 + off + 32 * bj); const float b[8] = {ub0(gw.x), ub1(gw.x), ub2(gw.x), ub3(gw.x), ub0(gw.y), ub1(gw.y), ub2(gw.y), ub3(gw.y)};
                    f32x4 v0 = acc[ai][bj][m][0], v1 = acc[ai][bj][m][1];
#pragma unroll
                    for (int e = 0; e < 4; ++e) { v0[e] *= b[e] * (MG_SCALE / (255.f * O_SCALE * WCAT_SCALE)); v1[e] *= b[4 + e] * (MG_SCALE / (255.f * O_SCALE * WCAT_SCALE)); }
                    wq_[bj].x = pk4_fp8(v0[0], v0[1], v0[2], v0[3]); wq_[bj].y = pk4_fp8(v1[0], v1[1], v1[2], v1[3]); }
                *(u32x4*)((unsigned char*)MG + off - 8 * fq + widen8_off(fq)) = widen8(wq_[0], wq_[1]); }
    }
};

struct EpiWout {
    static constexpr int MID_T = 0;
    __device__ __forceinline__ int min_vm(const Unit&) const { return 0; }
    bf16_t* X1B; float* SSQ; unsigned char* X18;
    __device__ __forceinline__ void init(Acc& acc, const Unit& u, int wr, int wc, int fr, int fq) const {
        const int row0 = u.pm * BM + wr * 64 + fr, col0 = u.pn * BM + 64 * wc + 8 * fq;
#pragma unroll
        for (int ai = 0; ai < 2; ++ai)
#pragma unroll
            for (int m = 0; m < 4; ++m) { const size_t off = (size_t)(row0 + ai * HALF + m * 16) * 1024 + col0;
#pragma unroll
                for (int bj = 0; bj < 2; ++bj) { float xb[8]; unpack8(*(const u32x4*)(X1B + off + 32 * bj), xb);
                    acc[ai][bj][m][0] = (f32x4){xb[0], xb[1], xb[2], xb[3]} * (MG_SCALE * WOUT_SCALE); acc[ai][bj][m][1] = (f32x4){xb[4], xb[5], xb[6], xb[7]} * (MG_SCALE * WOUT_SCALE); } }
    }
    __device__ __forceinline__ void mid(Acc&, const Unit&, int, int, int, int) const {}
    __device__ __forceinline__ void operator()(Acc& acc, const Unit& u, int wr, int wc, int fr, int fq) const {
        const int row0 = u.pm * BM + wr * 64 + fr, col0 = u.pn * BM + 64 * wc + 8 * fq;
#pragma unroll
        for (int ai = 0; ai < 2; ++ai)
#pragma unroll
            for (int m = 0; m < 4; ++m) { const int row = row0 + ai * HALF + m * 16; const size_t off = (size_t)row * 1024 + col0; float ss = 0.f; u32x2 wq_[2];
#pragma unroll
                for (int bj = 0; bj < 2; ++bj) { f32x4 v[2];
#pragma unroll
                    for (int n = 0; n < 2; ++n) { v[n] = acc[ai][bj][m][n] * (1.f / (MG_SCALE * WOUT_SCALE));
                        ss += (v[n][0] * v[n][0] + v[n][1] * v[n][1]) + (v[n][2] * v[n][2] + v[n][3] * v[n][3]); }
                    *(u32x4*)(X1B + off + 32 * bj) = pack8(v[0], v[1]);
                    wq_[bj].x = pk4_fp8(v[0][0] * X1_SCALE, v[0][1] * X1_SCALE, v[0][2] * X1_SCALE, v[0][3] * X1_SCALE); wq_[bj].y = pk4_fp8(v[1][0] * X1_SCALE, v[1][1] * X1_SCALE, v[1][2] * X1_SCALE, v[1][3] * X1_SCALE); }
                *(u32x4*)(X18 + off - 8 * fq + widen8_off(fq)) = widen8(wq_[0], wq_[1]);
                ss = fq_sum(ss);
                if (fq == 0) SSQ[(size_t)row * 16 + u.pn * 4 + wc] = ss;
                if (m & 1) asm volatile("" ::: "memory"); }
    }
};

struct EpiUp {
    static constexpr int MID_T = 0;
    __device__ __forceinline__ int min_vm(const Unit&) const { return 8; }
    const float* SSQ; bf16_t* U; LAS const float* r2tab; int pm0;
    __device__ __forceinline__ void init(Acc& acc, const Unit&, int, int, int, int) const {
#pragma unroll
        for (int a = 0; a < 2; ++a)
#pragma unroll
            for (int b = 0; b < 2; ++b)
#pragma unroll
                for (int m = 0; m < 4; ++m)
#pragma unroll
                    for (int n = 0; n < 2; ++n) acc[a][b][m][n] = (f32x4){0.f, 0.f, 0.f, 0.f};
    }
    __device__ __forceinline__ void mid(Acc&, const Unit&, int, int, int, int) const {}
    __device__ __forceinline__ void operator()(Acc& acc, const Unit& u, int wr, int wc, int fr, int fq) const {
        const int row0 = u.pm * BM + wr * 64 + fr, col0 = u.pn * BM + 64 * wc + 8 * fq;
#pragma unroll
        for (int ai = 0; ai < 2; ++ai)
#pragma unroll
            for (int m = 0; m < 4; ++m) { const int row = row0 + ai * HALF + m * 16; float r2;
                u32x2 wq_[2];
                if (u.pm == pm0) r2 = r2tab[row & 255];
                else { const f32x4* sp = (const f32x4*)(SSQ + (size_t)row * 16);
                    const f32x4 s0 = sp[0], s1 = sp[1], s2 = sp[2], s3 = sp[3]; const f32x4 st = (s0 + s1) + (s2 + s3);
                    r2 = __builtin_amdgcn_rcpf(((st[0] + st[1]) + (st[2] + st[3])) * (1.f / 1024.f) + EPS) * (1.f / ((X1_SCALE * W1_SCALE) * (X1_SCALE * W1_SCALE))); }
#pragma unroll
                for (int bj = 0; bj < 2; ++bj) { f32x4 v[2];
#pragma unroll
                    for (int n = 0; n < 2; ++n)
#pragma unroll
                        for (int e = 0; e < 4; ++e) { const float a = relu1(acc[ai][bj][m][n][e]); v[n][e] = a * a * (r2 * U_SCALE); }
                    wq_[bj].x = pk4_fp8(v[0][0], v[0][1], v[0][2], v[0][3]); wq_[bj].y = pk4_fp8(v[1][0], v[1][1], v[1][2], v[1][3]); }
                *(u32x4*)((unsigned char*)U + (size_t)row * FF + col0 - 8 * fq + widen8_off(fq)) = widen8(wq_[0], wq_[1]); }
    }
};

struct EpiDown {
    static constexpr int MID_T = 0;
    __device__ __forceinline__ int min_vm(const Unit&) const { return 0; }
    const bf16_t* X1B; float* OUT;
    __device__ __forceinline__ void init(Acc& acc, const Unit& u, int wr, int wc, int fr, int fq) const {
        const int row0 = u.pm * BM + wr * 64 + fr, col0 = u.pn * BM + 64 * wc + 8 * fq;
#pragma unroll
        for (int ai = 0; ai < 2; ++ai)
#pragma unroll
            for (int m = 0; m < 4; ++m) { const size_t off = (size_t)(row0 + ai * HALF + m * 16) * 1024 + col0;
#pragma unroll
                for (int bj = 0; bj < 2; ++bj) { float xb[8]; unpack8(*(const u32x4*)(X1B + off + 32 * bj), xb);
                    acc[ai][bj][m][0] = (f32x4){xb[0], xb[1], xb[2], xb[3]} * (U_SCALE * W2_SCALE); acc[ai][bj][m][1] = (f32x4){xb[4], xb[5], xb[6], xb[7]} * (U_SCALE * W2_SCALE); } }
    }
    __device__ __forceinline__ void mid(Acc&, const Unit&, int, int, int, int) const {}
    __device__ __forceinline__ void operator()(Acc& acc, const Unit& u, int wr, int wc, int fr, int fq) const {
        const int row0 = u.pm * BM + wr * 64 + fr, col0 = u.pn * BM + 64 * wc + 8 * fq;
#pragma unroll
        for (int ai = 0; ai < 2; ++ai)
#pragma unroll
            for (int m = 0; m < 4; ++m) { const size_t off = (size_t)(row0 + ai * HALF + m * 16) * 1024 + col0;
#pragma unroll
                for (int bj = 0; bj < 2; ++bj) { *(f32x4*)(OUT + off + 32 * bj) = acc[ai][bj][m][0] * (1.f / (U_SCALE * W2_SCALE)); *(f32x4*)(OUT + off + 32 * bj + 4) = acc[ai][bj][m][1] * (1.f / (U_SCALE * W2_SCALE)); }
                if (m & 1) asm volatile("" ::: "memory"); }
    }
};
}

namespace idx {
template <int CTRL> __device__ __forceinline__ unsigned dppmov(unsigned x) { return (unsigned)__builtin_amdgcn_update_dpp(0, (int)x, CTRL, 0xf, 0xf, false); }
__device__ __forceinline__ unsigned half_sum(unsigned x, int hi) {
    x += dppmov<0x128>(x); x += dppmov<0x124>(x); x += dppmov<0x122>(x); x += dppmov<0x121>(x);
    const unsigned lo = (unsigned)__builtin_amdgcn_readlane((int)x, 0) + (unsigned)__builtin_amdgcn_readlane((int)x, 16);
    const unsigned up = (unsigned)__builtin_amdgcn_readlane((int)x, 32) + (unsigned)__builtin_amdgcn_readlane((int)x, 48);
    return hi ? up : lo;
}
typedef unsigned short u16x2 __attribute__((ext_vector_type(2)));
__device__ __forceinline__ unsigned wlane(unsigned v, unsigned sval, int lane) { asm volatile("s_nop 1\n\tv_writelane_b32 %0, %1, %2" : "+v"(v) : "s"(sval), "n"(lane)); return v; }
#define WLANE4(a, b, c, d, x, y, lane) asm volatile("s_nop 1\n\tv_writelane_b32 %0, %4, %8\n\tv_writelane_b32 %1, %5, %8\n\tv_writelane_b32 %2, %6, %8\n\tv_writelane_b32 %3, %7, %8" \
        : "+v"(a), "+v"(b), "+v"(c), "+v"(d) : "s"((unsigned)(x)), "s"((unsigned)((x) >> 32)), "s"((unsigned)(y)), "s"((unsigned)((y) >> 32)), "n"(lane))
template <bool MAX> __device__ __forceinline__ float half_minmax(float x, int hi) {
#define MM(a, b) (MAX ? fmaxf((a), (b)) : fminf((a), (b)))
    x = MM(x, __uint_as_float(dppmov<0x128>(__float_as_uint(x)))); x = MM(x, __uint_as_float(dppmov<0x124>(__float_as_uint(x))));
    x = MM(x, __uint_as_float(dppmov<0x122>(__float_as_uint(x)))); x = MM(x, __uint_as_float(dppmov<0x121>(__float_as_uint(x))));
    const float lo = MM(__uint_as_float((unsigned)__builtin_amdgcn_readlane((int)__float_as_uint(x), 0)), __uint_as_float((unsigned)__builtin_amdgcn_readlane((int)__float_as_uint(x), 16)));
    const float up = MM(__uint_as_float((unsigned)__builtin_amdgcn_readlane((int)__float_as_uint(x), 32)), __uint_as_float((unsigned)__builtin_amdgcn_readlane((int)__float_as_uint(x), 48)));
#undef MM
    return hi ? up : lo;
}
__device__ __forceinline__ void idx_unit(int b, int qblk, const bf16_t* __restrict__ QIX, const bf16_t* __restrict__ KIX, const float* __restrict__ WIX, unsigned* __restrict__ MASK, LAS char* wlds) {
    int tid_ = threadIdx.x; asm volatile("" : "+v"(tid_));
    const int tid = tid_, lane = tid & 63, r32 = lane & 31, hi = lane >> 5; const int wid = __builtin_amdgcn_readfirstlane(tid >> 6);
    const size_t rowbase = (size_t)b * SEQ; const int tbase = qblk * 32 + wid * 4;
    const int ri = r32, rhi = (ri >> 2) & 1, blk = ri >> 3, qoff = (rhi ? 2 : 0) + (blk >> 1), head = (blk & 1) * 4 + (ri & 3);
    bf16x8 af[2];
#pragma unroll
    for (int ks = 0; ks < 2; ++ks) af[ks] = *(const bf16x8*)(QIX + (rowbase + tbase + qoff) * 256 + head * 32 + ks * 16 + hi * 8);
    const int qA = tbase + (hi ? 2 : 0), qB = qA + 1;
    float wA[8], wB[8];
    { const f32x4 a0 = *(const f32x4*)(WIX + (rowbase + qA) * 8), a1 = *(const f32x4*)(WIX + (rowbase + qA) * 8 + 4), b0 = *(const f32x4*)(WIX + (rowbase + qB) * 8), b1 = *(const f32x4*)(WIX + (rowbase + qB) * 8 + 4);
#pragma unroll
      for (int e = 0; e < 4; ++e) { wA[e] = a0[e]; wA[4 + e] = a1[e]; wB[e] = b0[e]; wB[4 + e] = b1[e]; } }
    const int jmax = qblk;
    { const GAS bf16_t* kp = (const GAS bf16_t*)(KIX + (rowbase + r32) * 32 + hi * 8);
      bf16x8 c0[4], c1[4], n0[4], n1[4];
#pragma unroll
      for (int u = 0; u < 4; ++u) { c0[u] = *(const GAS bf16x8*)(kp + (size_t)u * 1024); c1[u] = *(const GAS bf16x8*)(kp + (size_t)u * 1024 + 16); }
      LAS char* wp = wlds + lane * 4;
#define IDX_P1_GROUP(J0, CA, CB, NA, NB) { const int j0 = (J0); const int jn = (j0 + 4 <= 60) ? j0 + 4 : 60;        \
          _Pragma("unroll") for (int u = 0; u < 4; ++u) { NA[u] = *(const GAS bf16x8*)(kp + (size_t)(jn + u) * 1024); NB[u] = *(const GAS bf16x8*)(kp + (size_t)(jn + u) * 1024 + 16); } \
          f32x16 cc[4]; \
          _Pragma("unroll") for (int u = 0; u < 4; ++u) { cc[u] = f32x16{}; cc[u] = __builtin_amdgcn_mfma_f32_32x32x16_bf16(af[0], CA[u], cc[u], 0, 0, 0); } \
          _Pragma("unroll") for (int u = 0; u < 4; ++u) cc[u] = __builtin_amdgcn_mfma_f32_32x32x16_bf16(af[1], CB[u], cc[u], 0, 0, 0); \
          float sa_[4], sb_[4]; \
          _Pragma("unroll") for (int u = 0; u < 4; ++u) { float a0 = 0.f, a1 = 0.f, b0 = 0.f, b1 = 0.f; \
              _Pragma("unroll") for (int r = 0; r < 4; ++r) { a0 = fmaf(wA[r], pg8::relu1(cc[u][r]), a0); a1 = fmaf(wA[4 + r], pg8::relu1(cc[u][4 + r]), a1); b0 = fmaf(wB[r], pg8::relu1(cc[u][8 + r]), b0); b1 = fmaf(wB[4 + r], pg8::relu1(cc[u][12 + r]), b1); } \
              sa_[u] = a0 + a1; sb_[u] = b0 + b1; } \
          { typedef _Float16 h2_t __attribute__((ext_vector_type(2))); typedef float f2_t __attribute__((ext_vector_type(2)));        \
            _Pragma("unroll") for (int u = 0; u < 4; u += 2) { const int jj = (j0 + u) >> 1; \
                *(LAS h2_t*)(wp + jj * 256) = __builtin_convertvector((f2_t){sa_[u], sa_[u + 1]}, h2_t); \
                *(LAS h2_t*)(wp + 8192 + jj * 256) = __builtin_convertvector((f2_t){sb_[u], sb_[u + 1]}, h2_t); } } }
#pragma unroll 1
      for (int j8 = 0; j8 <= jmax; j8 += 8) {
          IDX_P1_GROUP(j8, c0, c1, n0, n1)
          if (j8 + 4 > jmax) break;
          IDX_P1_GROUP(j8 + 4, n0, n1, c0, c1)
      }
#undef IDX_P1_GROUP
    }
    const int nch = (jmax >> 3) + 1;
    unsigned pA[32], pB[32];
    asm volatile("s_waitcnt lgkmcnt(0)" ::: "memory");
#pragma unroll
    for (int ch = 0; ch < 8; ++ch) {
#pragma unroll
        for (int u = 0; u < 4; ++u) { pA[ch * 4 + u] = 0u; pB[ch * 4 + u] = 0u; }
        if (ch < nch) {
#pragma unroll
            for (int u = 0; u < 4; ++u) { const int jj = ch * 4 + u;
                typedef short s16x2_t __attribute__((ext_vector_type(2)));
                const unsigned ra = *(LAS const unsigned*)(wlds + lane * 4 + jj * 256), rb = *(LAS const unsigned*)(wlds + 8192 + lane * 4 + jj * 256);
                unsigned ka = ra ^ (__builtin_bit_cast(unsigned, __builtin_bit_cast(s16x2_t, ra) >> (short)15) | 0x80008000u), kb = rb ^ (__builtin_bit_cast(unsigned, __builtin_bit_cast(s16x2_t, rb) >> (short)15) | 0x80008000u);
                if (64 * jj + 63 > tbase) {
                    const int s0 = 64 * jj + r32, s1 = s0 + 32;
                    if (s0 > qA) ka &= 0xffff0000u; if (s1 > qA) ka &= 0x0000ffffu; if (s0 > qB) kb &= 0xffff0000u; if (s1 > qB) kb &= 0x0000ffffu; }
                pA[jj] = ka; pB[jj] = kb; }
        }
    }
    const unsigned nel = (unsigned)nch * 8u * 32u;
    auto count_lt = [&](unsigned cA, unsigned cB) -> unsigned {
        const unsigned c2A = cA | (cA << 16), c2B = cB | (cB << 16), one2 = 0x00010001u;
        u16x2 acA[4], acB[4];
#pragma unroll
        for (int u = 0; u < 4; ++u) { acA[u] = (u16x2){0, 0}; acB[u] = (u16x2){0, 0}; }
#pragma unroll
        for (int ch = 0; ch < 8; ++ch) {
            if (ch < nch) {
#pragma unroll
                for (int u = 0; u < 4; ++u) { const int jj = ch * 4 + u;
                    unsigned oA, oB;
                    asm("v_pk_sub_u16 %0, %2, %3 clamp\n\tv_pk_sub_u16 %1, %4, %5 clamp\n\tv_pk_min_u16 %0, %0, %6\n\tv_pk_min_u16 %1, %1, %6" : "=&v"(oA), "=&v"(oB) : "v"(c2A), "v"(pA[jj]), "v"(c2B), "v"(pB[jj]), "v"(one2));
                    acA[u] += __builtin_bit_cast(u16x2, oA); acB[u] += __builtin_bit_cast(u16x2, oB); }
            }
        }
        const u16x2 accA = (acA[0] + acA[1]) + (acA[2] + acA[3]), accB = (acB[0] + acB[1]) + (acB[2] + acB[3]);
        const unsigned a = __builtin_bit_cast(unsigned, accA), bq = __builtin_bit_cast(unsigned, accB);
        return half_sum(((a & 0xffffu) + (a >> 16)) | (((bq & 0xffffu) + (bq >> 16)) << 16), hi);
    };
    unsigned TA = 0u, TB = 0u, geTA = 256u, geTB = 256u;
    if (tbase + 3 >= 256) {
#pragma unroll 1
        for (int bit = 15; bit >= 0; --bit) {
            const unsigned cA = TA | (1u << bit), cB = TB | (1u << bit);
            const unsigned lt = count_lt(cA, cB);
            const unsigned geA = nel - (lt & 0xffffu), geB = nel - (lt >> 16);
            if (geA >= 256u) { TA = cA; geTA = geA; }
            if (geB >= 256u) { TB = cB; geTB = geB; }
        }
    }
    if (qA + 1 <= 256) TA = 1u;
    if (qB + 1 <= 256) TB = 1u;
    int exA, exB;
    exA = (int)geTA - 256; exB = (int)geTB - 256; if (qA + 1 <= 256) exA = 0; if (qB + 1 <= 256) exB = 0;
    unsigned m0 = 0u, m1 = 0u, m2 = 0u, m3 = 0u;
    const bool anyt = __any((exA > 0) || (exB > 0));
    unsigned t0 = 0u, t1 = 0u, t2 = 0u, t3 = 0u;
#pragma unroll
    for (int ch = 0; ch < 8; ++ch) {
        if (ch < nch) {
#pragma unroll
            for (int u = 0; u < 8; ++u) { const int j = ch * 8 + u;
                const unsigned eA = (j & 1) ? (pA[j >> 1] >> 16) : (pA[j >> 1] & 0xffffu), eB = (j & 1) ? (pB[j >> 1] >> 16) : (pB[j >> 1] & 0xffffu);
                const unsigned long long gA = __ballot(eA >= TA), gB = __ballot(eB >= TB);
                WLANE4(m0, m2, m1, m3, gA, gB, j);
                if (anyt) { const unsigned long long qA_ = __ballot(eA == TA), qB_ = __ballot(eB == TB);
                    WLANE4(t0, t2, t1, t3, qA_, qB_, j); } }
        }
    }
    if (anyt) {
#define IDX_DROP(mq, tq, exq) { int ex_ = (exq); \
            while (ex_ > 0) { const unsigned long long nz_ = __ballot(tq != 0u); if (nz_ == 0ull) break; \
                const int jt_ = 63 - __builtin_clzll(nz_); const unsigned w_ = (unsigned)__builtin_amdgcn_readlane((int)tq, jt_); const unsigned top_ = 0x80000000u >> __builtin_clz(w_); \
                if (lane == jt_) { tq &= ~top_; mq &= ~top_; } --ex_; } }
        const int e0 = __builtin_amdgcn_readlane(exA, 0), e2 = __builtin_amdgcn_readlane(exA, 32), e1 = __builtin_amdgcn_readlane(exB, 0), e3 = __builtin_amdgcn_readlane(exB, 32);
        IDX_DROP(m0, t0, e0) IDX_DROP(m1, t1, e1) IDX_DROP(m2, t2, e2) IDX_DROP(m3, t3, e3)
#undef IDX_DROP
    }
    unsigned* mp = MASK + (rowbase + tbase) * 64 + lane;
    asm volatile("global_store_dword %0, %1, off sc1\n\tglobal_store_dword %0, %2, off offset:256 sc1\n\tglobal_store_dword %0, %3, off offset:512 sc1\n\tglobal_store_dword %0, %4, off offset:768 sc1"
                 :: "v"(mp), "v"(m0), "v"(m1), "v"(m2), "v"(m3) : "memory");
}
}

namespace att {
typedef float f32x2 __attribute__((ext_vector_type(2)));
typedef LAS const char* lds_cptr;
__device__ __forceinline__ int crow(int r, int hi) { return (r & 3) + 8 * (r >> 2) + 4 * hi; }
__device__ __forceinline__ s16x4 vtr(lds_cptr p) { return __builtin_bit_cast(s16x4, __builtin_amdgcn_ds_read_tr16_b64_v4i16((LAS v4i16_t*)p)); }
constexpr int KVBUF = 16384;
constexpr int LDS_KV = 0, LDS_OST = 2 * KVBUF, LDS_WS = LDS_OST + 8 * 4096, LDS_MASK = LDS_WS + 8 * 256, MASK_STRIDE = 66, LDS_ATT_BYTES = LDS_MASK + 64 * MASK_STRIDE * 4;

struct TileLd { u32x4 k, v; };
__device__ __forceinline__ void tile_load(TileLd& t, const bf16_t* Kh, const bf16_t* Vh, int pitch, int key0, int wid, int lane) {
    t.k = *(const u32x4*)(Kh + (size_t)(key0 + lane) * pitch + wid * 8);
    t.v = *(const u32x4*)(Vh + (size_t)(key0 + 16 * (wid & 3) + (lane >> 2)) * pitch + (wid >> 2) * 32 + (lane & 3) * 8);
}
__device__ __forceinline__ void tile_store(const TileLd& t, LAS char* buf, int wid, int lane) {
    *(LAS u32x4*)(buf + wid * 1024 + lane * 16) = t.k;
    *(LAS u32x4*)(buf + 8192 + wid * 1024 + lane * 16) = t.v;
}
#define ATT_SBAR() __builtin_amdgcn_sched_barrier(0)
__device__ __forceinline__ void kload8(bf16x8 (&kf)[8], lds_cptr Kb, int r32, int hi) {
    lds_cptr kp = Kb + hi * 1024 + r32 * 16;
#pragma unroll
    for (int d0 = 0; d0 < 4; ++d0) { kf[2 * d0] = *(LAS const bf16x8*)(kp + d0 * 2048); kf[2 * d0 + 1] = *(LAS const bf16x8*)(kp + d0 * 2048 + 512); }
}
__device__ __forceinline__ void qkt_r(f32x16& p0, f32x16& p1, const bf16x8 (&kf)[8], const bf16x8* qr) {
#pragma unroll
    for (int d0 = 0; d0 < 4; ++d0) {
        p0 = __builtin_amdgcn_mfma_f32_32x32x16_bf16(kf[2 * d0], qr[d0], p0, 0, 0, 0);
        p1 = __builtin_amdgcn_mfma_f32_32x32x16_bf16(kf[2 * d0 + 1], qr[d0], p1, 0, 0, 0);
    }
}
__device__ __forceinline__ void vload16(s16x4 (&vl)[8], s16x4 (&vu)[8], lds_cptr Vb, int lane, int hi) {
    lds_cptr vp = Vb + ((lane >> 4) & 1) * 32 + (lane & 3) * 8 + (4 * hi + ((lane & 15) >> 2)) * 64;
#pragma unroll
    for (int d0 = 0; d0 < 2; ++d0)
#pragma unroll
        for (int ks = 0; ks < 4; ++ks) { vl[d0 * 4 + ks] = vtr(vp + d0 * 4096 + ks * 1024); vu[d0 * 4 + ks] = vtr(vp + d0 * 4096 + ks * 1024 + 512); }
}
__device__ __forceinline__ void pv_r(f32x16* o, const s16x4 (&vl)[8], const s16x4 (&vu)[8], const u32x4 (&pw)[4]) {
#pragma unroll
    for (int ks = 0; ks < 4; ++ks)
#pragma unroll
        for (int d0 = 0; d0 < 2; ++d0) { const s16x4 lo = vl[d0 * 4 + ks], up = vu[d0 * 4 + ks];
            const bf16x8 vf = (bf16x8){lo[0], lo[1], lo[2], lo[3], up[0], up[1], up[2], up[3]};
            o[d0] = __builtin_amdgcn_mfma_f32_32x32x16_bf16(__builtin_bit_cast(bf16x8, pw[ks]), vf, o[d0], 0, 0, 0); }
}
__device__ __forceinline__ void pack_p(u32x4 (&pw)[4], const f32x16& p0, const f32x16& p1) {
    pw[0] = (u32x4){cvtpk(p0[0], p0[1]), cvtpk(p0[2], p0[3]), cvtpk(p0[4], p0[5]), cvtpk(p0[6], p0[7])};
    pw[1] = (u32x4){cvtpk(p0[8], p0[9]), cvtpk(p0[10], p0[11]), cvtpk(p0[12], p0[13]), cvtpk(p0[14], p0[15])};
    pw[2] = (u32x4){cvtpk(p1[0], p1[1]), cvtpk(p1[2], p1[3]), cvtpk(p1[4], p1[5]), cvtpk(p1[6], p1[7])};
    pw[3] = (u32x4){cvtpk(p1[8], p1[9]), cvtpk(p1[10], p1[11]), cvtpk(p1[12], p1[13]), cvtpk(p1[14], p1[15])};
}
__device__ __forceinline__ void store_o(const f32x16* o, bf16_t* Ow_, int opitch, LAS char* stg, int lane, int r32, int hi) {
    unsigned char* Ow = (unsigned char*)Ow_;
    LAS unsigned char* s = (LAS unsigned char*)stg;
#pragma unroll
    for (int r = 0; r < 16; ++r) { const int orow = crow(r, hi);
        const unsigned pk = pk4_fp8(o[0][r] * O_SCALE, o[1][r] * O_SCALE, 0.f, 0.f);
        s[orow * 64 + r32] = (unsigned char)(pk & 0xffu); s[orow * 64 + 32 + r32] = (unsigned char)((pk >> 8) & 0xffu); }
    asm volatile("s_waitcnt lgkmcnt(0)" ::: "memory");
    { const int row = lane >> 1, hf = lane & 1; const u32x4 v0 = *(LAS const u32x4*)(s + row * 64 + hf * 32), v1 = *(LAS const u32x4*)(s + row * 64 + hf * 32 + 16);
      *(u32x4*)(Ow + (size_t)row * opitch + hf * 32) = v0; *(u32x4*)(Ow + (size_t)row * opitch + hf * 32 + 16) = v1; }
    asm volatile("s_waitcnt lgkmcnt(0)" ::: "memory");
}

__device__ __forceinline__ bool carry_done(float carry) { return __all(carry < 9.0949470177e-13f); }
__device__ __forceinline__ void sb_tile(LAS char* buf, int jb, const bf16x8* qr, f32x16* o, float& carry, LAS unsigned* dfl, int wid, int wq, int lane, int r32, int hi, int qrel) {
    const bool skip = (jb >= 0) && (64 * jb >= 32 * wq + 31);
    if (skip || carry_done(carry)) return;
    f32x16 p0 = f32x16{}, p1 = f32x16{};
    bf16x8 kf[8]; kload8(kf, (lds_cptr)buf, r32, hi); ATT_SBAR();
    qkt_r(p0, p1, kf, qr);
    s16x4 vl[8], vu[8]; vload16(vl, vu, (lds_cptr)buf + 8192, lane, hi); ATT_SBAR();
#pragma unroll
    for (int r = 0; r < 16; ++r) { p0[r] = __builtin_amdgcn_exp2f(p0[r]); p1[r] = __builtin_amdgcn_exp2f(p1[r]); }
    if (jb >= 0 && 64 * jb + 63 >= 32 * wq) {
#pragma unroll
        for (int r = 0; r < 16; ++r) { const int kv = 64 * jb + crow(r, hi); if (kv >= qrel) p0[r] = 0.f; if (kv + 32 >= qrel) p1[r] = 0.f; }
    }
    f32x16 r0, r1;
#pragma unroll
    for (int r = 0; r < 16; ++r) { r0[r] = __builtin_amdgcn_rcpf(1.f + p0[r]); r1[r] = __builtin_amdgcn_rcpf(1.f + p1[r]); }
    float pp[8], part[8];
#pragma unroll
    for (int a = 0; a < 8; ++a) {
        const float g = (a < 4) ? (r0[4 * a] * r0[4 * a + 1]) * (r0[4 * a + 2] * r0[4 * a + 3]) : (r1[4 * a - 16] * r1[4 * a - 15]) * (r1[4 * a - 14] * r1[4 * a - 13]);
        const auto rr = __builtin_amdgcn_permlane32_swap(__float_as_uint(g), __float_as_uint(g), false, false);
        const float x0 = __uint_as_float(rr[0]), x1 = __uint_as_float(rr[1]);
        pp[a] = x0 * x1;
        part[a] = hi ? 1.f : x1;
    }
    float sp = carry;
#pragma unroll
    for (int a = 7; a >= 0; --a) {
        const float E = sp * part[a];
        if (a < 4) { const float R3 = E * r0[4 * a + 3], R2 = R3 * r0[4 * a + 2], R1 = R2 * r0[4 * a + 1], R0 = R1 * r0[4 * a];
            p0[4 * a + 3] *= R3; p0[4 * a + 2] *= R2; p0[4 * a + 1] *= R1; p0[4 * a] *= R0; }
        else { const int c = 4 * a - 16; const float R3 = E * r1[c + 3], R2 = R3 * r1[c + 2], R1 = R2 * r1[c + 1], R0 = R1 * r1[c];
            p1[c + 3] *= R3; p1[c + 2] *= R2; p1[c + 1] *= R1; p1[c] *= R0; }
        sp *= pp[a];
    }
    carry = sp;
    u32x4 pw[4]; pack_p(pw, p0, p1);
    ATT_SBAR(); pv_r(o, vl, vu, pw);
    const bool done = carry_done(carry);
    if (lane == 0) dfl[wid] = done ? 1u : 0u;
}

constexpr int SBM_BUF = 2 * KVBUF, SBM_OST = 2 * SBM_BUF, SBM_WS = SBM_OST + 8 * 4096;
struct SbPre { TileLd f0, f1; };
__device__ __forceinline__ void sb_pre(SbPre& P, int b, int hp, int R, const bf16_t* __restrict__ Q, const bf16_t* __restrict__ K, const bf16_t* __restrict__ V, int wid, int lane, int r32, int hi, int hh, int wq) {
    const size_t rowbase = (size_t)b * SEQ; const int NT = 2 * (R + 1);
    const bf16_t* Kh = K + rowbase * 512 + (2 * hp) * 64; const bf16_t* Vh = V + rowbase * 512 + (2 * hp) * 64;
    tile_load(P.f0, Kh, Vh, 512, (NT - 1) * 64, wid, lane); tile_load(P.f1, Kh + 64, Vh + 64, 512, (NT - 1) * 64, wid, lane);
}
__device__ __forceinline__ void sb_pair(int b, int hp, int Ra, int Rb, const bf16_t* __restrict__ Q, const bf16_t* __restrict__ K, const bf16_t* __restrict__ V, bf16_t* __restrict__ OC, LAS char* shm) {
    int tid_ = threadIdx.x; asm volatile("" : "+v"(tid_));
    const int tid = tid_, lane = tid & 63, r32 = lane & 31, hi = lane >> 5; const int wid = __builtin_amdgcn_readfirstlane(tid >> 6);
    const int hh = (wid >> 1) & 1, wq = (wid & 1) + 2 * (wid >> 2), h = 2 * hp + hh;
    const size_t rowbase = (size_t)b * SEQ;
    const bf16_t* Kh = K + rowbase * 512 + (2 * hp) * 64; const bf16_t* Vh = V + rowbase * 512 + (2 * hp) * 64;
    LAS unsigned* dfl = (LAS unsigned*)(shm + SBM_WS);
    SbPre P, N;
    sb_pre(P, b, hp, Ra, Q, K, V, wid, lane, r32, hi, hh, wq);
#pragma unroll 1
    for (int un = 0; un < 2; ++un) {
        const int R = un ? Rb : Ra, q0 = R * 128, NT = 2 * (R + 1);
        bf16x8 qr[4];
        { const bf16_t* Qw = Q + (rowbase + q0 + wq * 32) * 512 + h * 64;
#pragma unroll
          for (int d0 = 0; d0 < 4; ++d0) qr[d0] = *(const bf16x8*)(Qw + (size_t)r32 * 512 + d0 * 16 + hi * 8); }
        f32x16 o[2]; o[0] = f32x16{}; o[1] = f32x16{};
        float carry = 1.f;
        const int qrel = wq * 32 + r32;
        TileLd tA0, tA1, tB0, tB1;
        tile_store(P.f0, shm, wid, lane); tile_store(P.f1, shm + KVBUF, wid, lane);
        tile_load(tA0, Kh, Vh, 512, (NT - 2) * 64, wid, lane); tile_load(tA1, Kh + 64, Vh + 64, 512, (NT - 2) * 64, wid, lane);
        if (lane == 0) dfl[wid] = 0u;
        if (un == 0) sb_pre(N, b, hp, Rb, Q, K, V, wid, lane, r32, hi, hh, wq);
#define SB_STEP(I, ST0, ST1, LD0, LD1) { const int i = (I); const int jt = NT - 1 - i; \
        __syncthreads(); \
        { const u32x4 fa = *(LAS const u32x4*)dfl, fb = *(LAS const u32x4*)(dfl + 4); if ((fa.x & fa.y & fa.z & fa.w & fb.x & fb.y & fb.z & fb.w) != 0u) break; } \
        if (i + 2 < NT) { tile_load(LD0, Kh, Vh, 512, (jt - 2) * 64, wid, lane); tile_load(LD1, Kh + 64, Vh + 64, 512, (jt - 2) * 64, wid, lane); } \
        sb_tile(shm + (i & 1) * SBM_BUF + hh * KVBUF, jt - 2 * R, qr, o, carry, dfl, wid, wq, lane, r32, hi, qrel); \
        if (i + 1 < NT) { tile_store(ST0, shm + ((i + 1) & 1) * SBM_BUF, wid, lane); tile_store(ST1, shm + ((i + 1) & 1) * SBM_BUF + KVBUF, wid, lane); } }
        for (int i2 = 0; i2 < NT; i2 += 2) {
            SB_STEP(i2, tA0, tA1, tB0, tB1)
            if (i2 + 1 < NT) SB_STEP(i2 + 1, tB0, tB1, tA0, tA1)
        }
#undef SB_STEP
        store_o(o, (bf16_t*)((unsigned char*)OC + (rowbase + q0 + wq * 32) * 1024 + h * 64), 1024, shm + SBM_OST + wid * 4096, lane, r32, hi);
        __syncthreads();
        P = N;
    }
}

__device__ __forceinline__ void sa_unit(int b, int g, int qb, const bf16_t* __restrict__ Q, const bf16_t* __restrict__ K, const bf16_t* __restrict__ V, const unsigned* __restrict__ MASK,
                                        bf16_t* __restrict__ OC, LAS char* shm) {
    const int tid = threadIdx.x, lane = tid & 63, r32 = lane & 31, hi = lane >> 5; const int wid = __builtin_amdgcn_readfirstlane(tid >> 6);
    const size_t rowbase = (size_t)b * SEQ; const int t0 = qb * 64, h = 4 * g + (wid >> 1), qloc = 32 * (wid & 1) + r32, t = t0 + qloc;
    const bf16_t* Qw = Q + (rowbase + t0 + 32 * (wid & 1)) * 512 + h * 64;
    const bf16_t* Kh = K + rowbase * 128 + g * 64; const bf16_t* Vh = V + rowbase * 128 + g * 64;
    bf16x8 qr[4];
#pragma unroll
    for (int d0 = 0; d0 < 4; ++d0) qr[d0] = *(const bf16x8*)(Qw + (size_t)r32 * 512 + d0 * 16 + hi * 8);
    LAS unsigned* mk = (LAS unsigned*)(shm + LDS_MASK);
#pragma unroll
    for (int i = 0; i < 8; ++i) { const int e = tid + i * 512, q = e >> 6, w = e & 63; mk[q * MASK_STRIDE + w] = MASK[(rowbase + t0 + q) * 64 + w]; }
    LAS float* wsf = (LAS float*)(shm + LDS_WS + wid * 256);
    const int NT = qb + 1;
    const float slope2 = __builtin_amdgcn_exp2f(-(float)(h + 1)) * 1.4426950408889634f;
    f32x16 o[2]; o[0] = f32x16{}; o[1] = f32x16{};
    float mrun = -1600.f, lsum = 0.f;
    TileLd tlA, tlB; tile_load(tlA, Kh, Vh, 128, (NT - 1) * 64, wid, lane);
    tile_store(tlA, shm + LDS_KV, wid, lane);
    if (NT > 1) tile_load(tlA, Kh, Vh, 128, (NT - 2) * 64, wid, lane);
    auto step = [&](const int i, TileLd& tst, TileLd& tld) {
        const int jt = NT - 1 - i;
        __syncthreads();
        if (i + 2 < NT) tile_load(tld, Kh, Vh, 128, (jt - 2) * 64, wid, lane);
        LAS char* buf = shm + LDS_KV + (i & 1) * KVBUF;
        bf16x8 kf[8]; kload8(kf, (lds_cptr)buf, r32, hi);
        const u32x2 mw = *(LAS const u32x2*)(mk + qloc * MASK_STRIDE + 2 * jt);
        ATT_SBAR();
        const unsigned w0 = mw.x >> (4 * hi), w1 = mw.y >> (4 * hi);
        const float base = slope2 * (float)(64 * jt + 4 * hi - t) - mrun;
        f32x16 p0, p1;
#pragma unroll
        for (int r = 0; r < 16; ++r) { const int cb = (r & 3) + 8 * (r >> 2); p0[r] = fmaf(slope2, (float)cb, base); p1[r] = fmaf(slope2, (float)(cb + 32), base); }
        qkt_r(p0, p1, kf, qr);
        s16x4 vl[8], vu[8]; vload16(vl, vu, (lds_cptr)buf + 8192, lane, hi); ATT_SBAR();
#pragma unroll
        for (int r = 0; r < 16; ++r) { const int cb = (r & 3) + 8 * (r >> 2);
            const unsigned m0 = (unsigned)__builtin_amdgcn_sbfe((int)w0, cb, 1), m1 = (unsigned)__builtin_amdgcn_sbfe((int)w1, cb, 1);
            p0[r] = __uint_as_float((__float_as_uint(p0[r]) & m0) | (0xf149f2cau & ~m0)); p1[r] = __uint_as_float((__float_as_uint(p1[r]) & m1) | (0xf149f2cau & ~m1)); }
        float rm;
        { float a = fmaxf(fmaxf(p0[0], p0[1]), p1[0]), bq = fmaxf(fmaxf(p0[2], p0[3]), p1[1]); a = fmaxf(fmaxf(a, p1[2]), p1[3]);
#pragma unroll
          for (int r = 4; r < 16; r += 4) { a = fmaxf(fmaxf(a, p0[r]), p0[r + 1]); bq = fmaxf(fmaxf(bq, p0[r + 2]), p0[r + 3]); a = fmaxf(fmaxf(a, p1[r]), p1[r + 1]); bq = fmaxf(fmaxf(bq, p1[r + 2]), p1[r + 3]); }
          rm = fmaxf(a, bq); }
        { const auto rr = __builtin_amdgcn_permlane32_swap(__float_as_uint(rm), __float_as_uint(rm), false, false); rm = fmaxf(__uint_as_float(rr[0]), __uint_as_float(rr[1])); }
        if (__any(rm > 8.f)) {
            const float dl = fmaxf(rm, 0.f), f = __builtin_amdgcn_exp2f(-dl);
            lsum *= f; mrun += dl;
#pragma unroll
            for (int r = 0; r < 16; ++r) { p0[r] -= dl; p1[r] -= dl; }
            if (hi == 0) wsf[r32] = f;
            asm volatile("s_waitcnt lgkmcnt(0)" ::: "memory");
#pragma unroll
            for (int r = 0; r < 16; ++r) { const float fr_ = wsf[crow(r, hi)]; o[0][r] *= fr_; o[1][r] *= fr_; }
        }
        float ps = 0.f;
#pragma unroll
        for (int r = 0; r < 16; ++r) { p0[r] = __builtin_amdgcn_exp2f(p0[r]); p1[r] = __builtin_amdgcn_exp2f(p1[r]); ps += p0[r] + p1[r]; }
        lsum += ps;
        u32x4 pw[4]; pack_p(pw, p0, p1);
        ATT_SBAR(); pv_r(o, vl, vu, pw);
        if (i + 1 < NT) tile_store(tst, shm + LDS_KV + ((i + 1) & 1) * KVBUF, wid, lane);
    };
    for (int i2 = 0; i2 < NT; i2 += 2) { step(i2, tlA, tlB); if (i2 + 1 < NT) step(i2 + 1, tlB, tlA); }
    { const auto rr = __builtin_amdgcn_permlane32_swap(__float_as_uint(lsum), __float_as_uint(lsum), false, false); lsum = __uint_as_float(rr[0]) + __uint_as_float(rr[1]); }
    if (hi == 0) wsf[32 + r32] = lsum;
    asm volatile("s_waitcnt lgkmcnt(0)" ::: "memory");
#pragma unroll
    for (int r = 0; r < 16; ++r) { const float rl = __builtin_amdgcn_rcpf(wsf[32 + crow(r, hi)]); o[0][r] *= rl; o[1][r] *= rl; }
    store_o(o, (bf16_t*)((unsigned char*)OC + (rowbase + t0 + 32 * (wid & 1)) * 1024 + 512 + h * 64), 1024, shm + LDS_OST + wid * 4096, lane, r32, hi);
    __syncthreads();
}

constexpr int SA2_LDS_KV = 0, SA2_LDS_OST = 4 * KVBUF, SA2_LDS_WS = SA2_LDS_OST + 8 * 4096, SA2_LDS_MASK = SA2_LDS_WS + 8 * 256, SA2_LDS_BYTES = SA2_LDS_MASK + 64 * MASK_STRIDE * 4;
__device__ __forceinline__ void sa_unit2(int b, int g, int qb, const bf16_t* __restrict__ Q, const bf16_t* __restrict__ K, const bf16_t* __restrict__ V, const unsigned* __restrict__ MASK,
                                         bf16_t* __restrict__ OC, LAS char* shm) {
    int tid_ = threadIdx.x; asm volatile("" : "+v"(tid_));
    const int tid = tid_, lane = tid & 63, r32 = lane & 31, hi = lane >> 5; const int wid = __builtin_amdgcn_readfirstlane(tid >> 6);
    const size_t rowbase = (size_t)b * SEQ; const int t0 = qb * 64, h = 4 * g + (wid >> 1), qloc = 32 * (wid & 1) + r32, t = t0 + qloc;
    const bf16_t* Qw = Q + (rowbase + t0 + 32 * (wid & 1)) * 512 + h * 64;
    const bf16_t* Kh = K + rowbase * 128 + g * 64; const bf16_t* Vh = V + rowbase * 128 + g * 64;
    bf16x8 qr[4];
#pragma unroll
    for (int d0 = 0; d0 < 4; ++d0) qr[d0] = *(const bf16x8*)(Qw + (size_t)r32 * 512 + d0 * 16 + hi * 8);
    LAS unsigned* mk = (LAS unsigned*)(shm + SA2_LDS_MASK);
#pragma unroll
    for (int i = 0; i < 8; ++i) { const int e = tid + i * 512, q = e >> 6, w = e & 63; mk[q * MASK_STRIDE + w] = MASK[(rowbase + t0 + q) * 64 + w]; }
    LAS float* wsf = (LAS float*)(shm + SA2_LDS_WS + wid * 256);
    const int NT = qb + 1;
    const float slope2 = __builtin_amdgcn_exp2f(-(float)(h + 1)) * 1.4426950408889634f; const f32x2 d2v = (f32x2){2.f * slope2, 2.f * slope2}, d6v = (f32x2){6.f * slope2, 6.f * slope2};
    f32x16 o[2]; o[0] = f32x16{}; o[1] = f32x16{};
    float mrun = -1600.f, lsum = 0.f;
    lds_cptr kvb = (lds_cptr)(shm + SA2_LDS_KV);
    lds_cptr vrd = kvb + 8192 + ((lane >> 4) & 1) * 32 + (lane & 3) * 8 + (4 * hi + ((lane & 15) >> 2)) * 64;
    lds_cptr krd = kvb + hi * 1024 + r32 * 16;
    LAS const unsigned* mkq = mk + qloc * MASK_STRIDE;
    TileLd tlA;
    { TileLd tl0, tl1;
      tile_load(tl0, Kh, Vh, 128, (NT - 1) * 64, wid, lane);
      if (NT > 1) tile_load(tl1, Kh, Vh, 128, (NT - 2) * 64, wid, lane);
      if (NT > 2) tile_load(tlA, Kh, Vh, 128, (NT - 3) * 64, wid, lane);
      tile_store(tl0, shm + SA2_LDS_KV, wid, lane);
      if (NT > 1) tile_store(tl1, shm + SA2_LDS_KV + KVBUF, wid, lane); }
    f32x16 X0, X1, Y0, Y1;
    bf16x8 kr[3]; s16x4 vlr[3], vur[3]; u32x4 pw[4];
#define SA2_MW(st) const int jtc_ = (NT - 1 - (st)) < 0 ? 0 : (NT - 1 - (st)); const u32x2 mw_ = *(LAS const u32x2*)(mkq + 2 * jtc_); \
        const unsigned w0_ = mw_.x >> (4 * hi), w1_ = mw_.y >> (4 * hi); const float base_ = slope2 * (float)(64 * jtc_ + 4 * hi - t) - mrun; f32x2 bvr_ = (f32x2){base_, base_ + slope2};
#define SA2_CI(C, r, w, add) { const int cb_ = ((r) & 3) + 8 * ((r) >> 2); const unsigned m_ = (unsigned)__builtin_amdgcn_sbfe((int)(w), cb_, 1), n_ = (unsigned)__builtin_amdgcn_sbfe((int)(w), cb_ + 1, 1); \
        const f32x2 bv_ = bvr_; bvr_ += ((r) & 2) ? d6v : d2v; float cv_, dv_;       \
        asm("v_bfi_b32 %0, %1, %2, %3" : "=v"(cv_) : "v"(m_), "v"(bv_.x), "v"(negbig)); asm("v_bfi_b32 %0, %1, %2, %3" : "=v"(dv_) : "v"(n_), "v"(bv_.y), "v"(negbig)); C[r] = cv_; C[(r) + 1] = dv_; }
#define SA2_MAX(C0, C1, rm) { float a_ = fmaxf(fmaxf(C0[0], C0[1]), C1[0]), b_ = fmaxf(fmaxf(C0[2], C0[3]), C1[1]); a_ = fmaxf(fmaxf(a_, C1[2]), C1[3]); \
        _Pragma("unroll") for (int r = 4; r < 16; r += 4) { a_ = fmaxf(fmaxf(a_, C0[r]), C0[r + 1]); b_ = fmaxf(fmaxf(b_, C0[r + 2]), C0[r + 3]); a_ = fmaxf(fmaxf(a_, C1[r]), C1[r + 1]); b_ = fmaxf(fmaxf(b_, C1[r + 2]), C1[r + 3]); } \
        rm = fmaxf(a_, b_); const auto rr_ = __builtin_amdgcn_permlane32_swap(__float_as_uint(rm), __float_as_uint(rm), false, false); rm = fmaxf(__uint_as_float(rr_[0]), __uint_as_float(rr_[1])); }
#define SA2_DECIDE(C0, C1) { float rm_; SA2_MAX(C0, C1, rm_); resc = false; \
        if (__any(rm_ > 8.f)) { const float dl_ = fmaxf(rm_, 0.f), f_ = __builtin_amdgcn_exp2f(-dl_); lsum *= f_; mrun += dl_; \
            _Pragma("unroll") for (int r = 0; r < 16; ++r) { C0[r] -= dl_; C1[r] -= dl_; } \
            if (hi == 0) wsf[r32] = f_; resc = true; } }
#define SA2_RESC() { if (resc) { asm volatile("s_waitcnt lgkmcnt(0)" ::: "memory"); _Pragma("unroll") for (int r = 0; r < 16; ++r) { const float fr_ = wsf[crow(r, hi)]; o[0][r] *= fr_; o[1][r] *= fr_; } } }
#define SA2_KLD(slot, gi) kr[slot] = *(LAS const bf16x8*)(kb_ + ((gi) >> 1) * 2048 + ((gi) & 1) * 512)
#define SA2_VIDX(gi) ((((gi) & 1) * 4) + ((gi) >> 1))
#define SA2_VLD(slot, gi) { vlr[slot] = vtr(vb_ + (SA2_VIDX(gi) >> 2) * 4096 + (SA2_VIDX(gi) & 3) * 1024); vur[slot] = vtr(vb_ + (SA2_VIDX(gi) >> 2) * 4096 + (SA2_VIDX(gi) & 3) * 1024 + 512); }
    bool resc = false;
    const float negbig = -1e30f;
    __syncthreads();
    { SA2_MW(0)
#pragma unroll
      for (int r = 0; r < 16; r += 2) SA2_CI(X0, r, w0_, 0)
#pragma unroll
      for (int r = 0; r < 16; r += 2) SA2_CI(X1, r, w1_, 32)
      { bf16x8 kf[8]; kload8(kf, kvb, r32, hi); ATT_SBAR(); qkt_r(X0, X1, kf, qr); }
      SA2_DECIDE(X0, X1)
#pragma unroll
      for (int r = 0; r < 16; ++r) { X0[r] = __builtin_amdgcn_exp2f(X0[r]); X1[r] = __builtin_amdgcn_exp2f(X1[r]); }
      if (NT > 1) { SA2_MW(1)
#pragma unroll
          for (int r = 0; r < 16; r += 2) SA2_CI(Y0, r, w0_, 0)
#pragma unroll
          for (int r = 0; r < 16; r += 2) SA2_CI(Y1, r, w1_, 32) }
      if (NT > 2) tile_store(tlA, shm + SA2_LDS_KV + 2 * KVBUF, wid, lane);
    }
#define SA2_GAPA(gi, C, s0, s1, s2, s3, pk) { \
        C = __builtin_amdgcn_mfma_f32_32x32x16_bf16(kr[(gi) % 3], qr[(gi) >> 1], C, 0, 0, 0); \
        if ((gi) + 3 < 8) SA2_KLD((gi) % 3, (gi) + 3); \
        sacc += (f32x2){s0, s1}; if ((gi) < 7) sacc += (f32x2){s2, s3}; asm volatile("" : "+v"(sacc)); pk; asm volatile("" : "+v"(pw[(gi) >> 1])); ATT_SBAR(); }
#define SA2_GAPB(gi, C, cb0, Pn, wn, addn) { \
        o[(gi) & 1] = __builtin_amdgcn_mfma_f32_32x32x16_bf16(__builtin_bit_cast(bf16x8, pw[(gi) >> 1]), (bf16x8){vlr[(gi) % 3][0], vlr[(gi) % 3][1], vlr[(gi) % 3][2], vlr[(gi) % 3][3], \
            vur[(gi) % 3][0], vur[(gi) % 3][1], vur[(gi) % 3][2], vur[(gi) % 3][3]}, o[(gi) & 1], 0, 0, 0); \
        if ((gi) + 3 < 8) SA2_VLD((gi) % 3, (gi) + 3) \
        C[cb0] = __builtin_amdgcn_exp2f(C[cb0]); C[cb0 + 1] = __builtin_amdgcn_exp2f(C[cb0 + 1]); C[cb0 + 2] = __builtin_amdgcn_exp2f(C[cb0 + 2]); C[cb0 + 3] = __builtin_amdgcn_exp2f(C[cb0 + 3]); \
        SA2_CI(Pn, cb0, wn, addn) SA2_CI(Pn, cb0 + 2, wn, addn) asm volatile("" : "+v"(C), "+v"(Pn)); ATT_SBAR(); }
#define SA2_STEP(I, C0, C1, P0, P1) { const int i = (I); \
        __syncthreads(); \
        if (i + 2 < NT) tile_load(tlA, Kh, Vh, 128, (NT - 3 - i) * 64, wid, lane); \
        lds_cptr kb_ = krd + (i & 3) * KVBUF; lds_cptr vb_ = vrd + ((i - 1) & 3) * KVBUF; \
        SA2_KLD(0, 0); SA2_KLD(1, 1); SA2_KLD(2, 2); \
        f32x2 sacc = (f32x2){P0[0], P0[1]}; ATT_SBAR(); \
        SA2_GAPA(0, C0, P0[2], P0[3], P0[4], P0[5],     (pw[0].x = cvtpk(P0[0], P0[1]), pw[0].y = cvtpk(P0[2], P0[3]))) \
        SA2_GAPA(1, C1, P0[6], P0[7], P0[8], P0[9],     (pw[0].z = cvtpk(P0[4], P0[5]), pw[0].w = cvtpk(P0[6], P0[7]))) \
        SA2_GAPA(2, C0, P0[10], P0[11], P0[12], P0[13], (pw[1].x = cvtpk(P0[8], P0[9]), pw[1].y = cvtpk(P0[10], P0[11]))) \
        SA2_GAPA(3, C1, P0[14], P0[15], P1[0], P1[1],   (pw[1].z = cvtpk(P0[12], P0[13]), pw[1].w = cvtpk(P0[14], P0[15]))) \
        SA2_GAPA(4, C0, P1[2], P1[3], P1[4], P1[5],     (pw[2].x = cvtpk(P1[0], P1[1]), pw[2].y = cvtpk(P1[2], P1[3]))) \
        SA2_GAPA(5, C1, P1[6], P1[7], P1[8], P1[9],     (pw[2].z = cvtpk(P1[4], P1[5]), pw[2].w = cvtpk(P1[6], P1[7]))) \
        SA2_GAPA(6, C0, P1[10], P1[11], P1[12], P1[13], (pw[3].x = cvtpk(P1[8], P1[9]), pw[3].y = cvtpk(P1[10], P1[11]))) \
        SA2_GAPA(7, C1, P1[14], P1[15], 0.f, 0.f,       (pw[3].z = cvtpk(P1[12], P1[13]), pw[3].w = cvtpk(P1[14], P1[15]))) \
        lsum += sacc.x + sacc.y; \
        SA2_VLD(0, 0) SA2_VLD(1, 1) SA2_VLD(2, 2) ATT_SBAR(); \
        SA2_DECIDE(C0, C1) \
        SA2_MW(i + 1) ATT_SBAR(); \
        SA2_GAPB(0, C0, 0,  P0, w0_, 0)  SA2_GAPB(1, C0, 4,  P0, w0_, 0)  SA2_GAPB(2, C0, 8,  P0, w0_, 0)  SA2_GAPB(3, C0, 12, P0, w0_, 0) \
        SA2_GAPB(4, C1, 0,  P1, w1_, 32) SA2_GAPB(5, C1, 4,  P1, w1_, 32) SA2_GAPB(6, C1, 8,  P1, w1_, 32) SA2_GAPB(7, C1, 12, P1, w1_, 32) \
        SA2_RESC() \
        if (i + 2 < NT) tile_store(tlA, shm + SA2_LDS_KV + ((i + 2) & 3) * KVBUF, wid, lane); }
    for (int i2 = 1; i2 < NT; i2 += 2) {
        SA2_STEP(i2, Y0, Y1, X0, X1)
        if (i2 + 1 < NT) SA2_STEP(i2 + 1, X0, X1, Y0, Y1)
    }
    { __syncthreads();
      s16x4 vl[8], vu[8]; vload16(vl, vu, kvb + ((NT - 1) & 3) * KVBUF + 8192, lane, hi);
      float ps = 0.f;
      if (NT & 1) {
#pragma unroll
          for (int r = 0; r < 16; ++r) ps += X0[r] + X1[r];
          pack_p(pw, X0, X1);
      } else {
#pragma unroll
          for (int r = 0; r < 16; ++r) ps += Y0[r] + Y1[r];
          pack_p(pw, Y0, Y1);
      }
      lsum += ps;
      pv_r(o, vl, vu, pw);
    }
    { const auto rr = __builtin_amdgcn_permlane32_swap(__float_as_uint(lsum), __float_as_uint(lsum), false, false); lsum = __uint_as_float(rr[0]) + __uint_as_float(rr[1]); }
    if (hi == 0) wsf[32 + r32] = lsum;
    asm volatile("s_waitcnt lgkmcnt(0)" ::: "memory");
#pragma unroll
    for (int r = 0; r < 16; ++r) { const float rl = __builtin_amdgcn_rcpf(wsf[32 + crow(r, hi)]); o[0][r] *= rl; o[1][r] *= rl; }
    store_o(o, (bf16_t*)((unsigned char*)OC + (rowbase + t0 + 32 * (wid & 1)) * 1024 + 512 + h * 64), 1024, shm + SA2_LDS_OST + wid * 4096, lane, r32, hi);
    __syncthreads();
#undef SA2_MW
#undef SA2_CI
#undef SA2_MAX
#undef SA2_DECIDE
#undef SA2_RESC
#undef SA2_GAPA
#undef SA2_GAPB
#undef SA2_STEP
#undef SA2_KLD
#undef SA2_VIDX
#undef SA2_VLD
}
}

constexpr int NWAVES = 8;
constexpr int RING_BYTES = 131072, LDSCTL_OFF = RING_BYTES, MISC_OFF = LDSCTL_OFF + 320, LDS_BYTES = 147456;
static_assert(att::LDS_ATT_BYTES <= RING_BYTES && att::SA2_LDS_BYTES <= RING_BYTES, "attention LDS");
#define RLX_AGENT __ATOMIC_RELAXED, __HIP_MEMORY_SCOPE_AGENT
#define XB_TMO      128
#define XB_XCNT(j)  (256  + 64 * (j))
#define XB_XSUB(j)  (1280 + 64 * (j))
#define XB_XGEN(j)  (2304 + 64 * (j))
#define XB_TOP      3328
#define XB_TOPGEN   3392
#define XCD_BAR_WORDS 3456
#define XB_SPIN_CAP (1u << 18)
__device__ __forceinline__ unsigned xb_ld(unsigned* p)              { return __hip_atomic_load(p, __ATOMIC_RELAXED, __HIP_MEMORY_SCOPE_AGENT); }
__device__ __forceinline__ unsigned xb_add(unsigned* p, unsigned v) { return __hip_atomic_fetch_add(p, v, __ATOMIC_RELAXED, __HIP_MEMORY_SCOPE_AGENT); }
__device__ __forceinline__ unsigned xb_xcc_id() { return (unsigned)__builtin_amdgcn_s_getreg((3 << 11) | 20) & 0xFu; }
#define XB_SPIN(cond, bar) do { unsigned _sp = 0; while (cond) { __builtin_amdgcn_s_sleep(1); \
    if ((++_sp & 255u) == 0u) { if (xb_ld(&(bar)[XB_TMO])) break; if (_sp > XB_SPIN_CAP) { atomicAdd(&(bar)[XB_TMO], 1u); break; } } } } while (0)
struct XcdBarrier { unsigned* bar; unsigned x; volatile LAS unsigned* st; };
__device__ __forceinline__ XcdBarrier xcd_barrier_post(unsigned* bar, volatile LAS unsigned* st) {
    XcdBarrier b; b.bar = bar; b.x = xb_xcc_id(); b.st = st;
    if (threadIdx.x == 0) (void)xb_add(&bar[XB_XCNT(b.x)], 1u);
    return b;
}
__device__ __forceinline__ void xcd_barrier_complete(unsigned* bar, unsigned x, unsigned& nloc, unsigned& nx) {
    const unsigned G = gridDim.x * gridDim.y * gridDim.z;
    unsigned sum, cnt, mine, sp = 0u;
    for (;;) {
        sum = 0u; cnt = 0u; mine = 0u;
#pragma unroll
        for (unsigned j = 0; j < 16; ++j) { const unsigned c = xb_ld(&bar[XB_XCNT(j)]); sum += c; cnt += (c > 0u) ? 1u : 0u; mine = (j == x) ? c : mine; }
        if (sum == G) break;
        __builtin_amdgcn_s_sleep(1);
        if ((++sp & 255u) == 0u) { if (xb_ld(&bar[XB_TMO])) break; if (sp > XB_SPIN_CAP) { atomicAdd(&bar[XB_TMO], 1u); break; } }
    }
    nloc = mine > 0u ? mine : 1u; nx = cnt > 0u ? cnt : 1u;
}
template <bool LOCAL = false>
__device__ __forceinline__ void xcd_barrier(const XcdBarrier& b) {
    asm volatile("s_waitcnt vmcnt(0)" ::: "memory");
    __syncthreads();
    if (threadIdx.x == 0) {
        unsigned* bar = b.bar;
        __builtin_amdgcn_s_waitcnt(0);
        unsigned nloc = b.st[0], nx = b.st[1];
        if (nloc == 0u) { xcd_barrier_complete(bar, b.x, nloc, nx); b.st[0] = nloc; b.st[1] = nx; }
        const unsigned old = xb_add(&bar[XB_XSUB(b.x)], 1u);
        const unsigned gen = old / nloc;
        if constexpr (LOCAL) {
            const unsigned target = (gen + 1u) * nloc;
            if (old + 1u != target) XB_SPIN(xb_ld(&bar[XB_XSUB(b.x)]) < target, bar);
            __builtin_amdgcn_fence(__ATOMIC_ACQUIRE, "agent");
            asm volatile("s_waitcnt vmcnt(0)" ::: "memory");
            if (old + 1u == target) xb_add(&bar[XB_XGEN(b.x)], 1u);
        } else
        if (old + 1u == (gen + 1u) * nloc) {
            if constexpr (!LOCAL) __builtin_amdgcn_fence(__ATOMIC_RELEASE, "agent");
            asm volatile("s_waitcnt vmcnt(0)" ::: "memory");
            if constexpr (!LOCAL) {
                const unsigned og = xb_add(&bar[XB_TOP], 1u);
                const unsigned tg = og / nx;
                if (og + 1u == (tg + 1u) * nx) xb_add(&bar[XB_TOPGEN], 1u);
                else XB_SPIN(xb_ld(&bar[XB_TOPGEN]) == tg, bar);
            }
            __builtin_amdgcn_fence(__ATOMIC_ACQUIRE, "agent");
            xb_add(&bar[XB_XGEN(b.x)], 1u);
            asm volatile("s_waitcnt vmcnt(0)" ::: "memory");
        } else {
            XB_SPIN((int)(xb_ld(&bar[XB_XGEN(b.x)]) - gen) <= 0, bar);
            __builtin_amdgcn_fence(__ATOMIC_ACQUIRE, "agent");
            asm volatile("s_waitcnt vmcnt(0)" ::: "memory");
        }
    }
    __syncthreads();
}

__device__ __forceinline__ void wait_count(unsigned* p, unsigned target) {
    if (threadIdx.x == 0) { unsigned sp = 0; while (xb_ld(p) < target) { __builtin_amdgcn_s_sleep(2); if (++sp > (1u << 22)) break; }
        __builtin_amdgcn_fence(__ATOMIC_ACQUIRE, "agent"); asm volatile("s_waitcnt vmcnt(0)" ::: "memory"); }
    __syncthreads();
}
struct SeamPre {
    static constexpr bool ON = true;
    const XcdBarrier& b; bool en, local; unsigned old_ = 0u, nloc_ = 1u;
    __device__ __forceinline__ void arrive() {
        if (!en) return;
        if (!local) { xcd_barrier(b); return; }
        asm volatile("s_waitcnt vmcnt(0)" ::: "memory");
        __syncthreads();
        if (threadIdx.x == 0) {
            unsigned* bar = b.bar;
            __builtin_amdgcn_s_waitcnt(0);
            unsigned nloc = b.st[0], nx = b.st[1];
            if (nloc == 0u) { xcd_barrier_complete(bar, b.x, nloc, nx); b.st[0] = nloc; b.st[1] = nx; }
            nloc_ = nloc; old_ = xb_add(&bar[XB_XSUB(b.x)], 1u);
        }
    }
    __device__ __forceinline__ void wait() {
        if (!en || !local) return;
        if (threadIdx.x == 0) {
            unsigned* bar = b.bar;
            const unsigned target = (old_ / nloc_ + 1u) * nloc_;
            if (old_ + 1u != target) XB_SPIN(xb_ld(&bar[XB_XSUB(b.x)]) < target, bar);
            __builtin_amdgcn_fence(__ATOMIC_ACQUIRE, "agent");
            asm volatile("s_waitcnt vmcnt(0)" ::: "memory");
            if (old_ + 1u == target) xb_add(&bar[XB_XGEN(b.x)], 1u);
        }
        __syncthreads();
    }
};
struct SeamPreTab {
    static constexpr bool ON = true;
    SeamPre s; const float* SSQ; LAS float* r2tab; int pm0;
    __device__ __forceinline__ void arrive() { s.arrive(); }
    __device__ __forceinline__ void wait() {
        s.wait();
        if (pm0 >= 0 && threadIdx.x < 256) { const f32x4* sp = (const f32x4*)(SSQ + (size_t)(256 * pm0 + threadIdx.x) * 16); const f32x4 s0 = sp[0], s1 = sp[1], s2 = sp[2], s3 = sp[3]; const f32x4 st = (s0 + s1) + (s2 + s3);
            r2tab[threadIdx.x] = __builtin_amdgcn_rcpf(((st[0] + st[1]) + (st[2] + st[3])) * (1.f / 1024.f) + EPS) * (1.f / ((X1_SCALE * W1_SCALE) * (X1_SCALE * W1_SCALE))); }
        __syncthreads();
    }
};
__device__ __forceinline__ float wave_sum(float v) {
#pragma unroll
    for (int o = 1; o < 64; o <<= 1) v += __shfl_xor(v, o);
    return v;
}
__device__ __forceinline__ void transpose_item(const float* __restrict__ W, int ldw, int sk0, int srccol, const float* __restrict__ kscale, bf16_t* __restrict__ WT, int dK, int drow0, int dk0, LAS float* scr, int lane) {
    float v[32];
    const float* wp = W + (size_t)(sk0 + (lane >> 5)) * ldw + (srccol >= 0 ? srccol : 0);
#pragma unroll
    for (int i = 0; i < 32; ++i) v[i] = (srccol >= 0) ? wp[(size_t)(2 * i) * ldw] : 0.f;
    if (kscale) {
#pragma unroll
        for (int i = 0; i < 32; ++i) v[i] *= kscale[sk0 + 2 * i + (lane >> 5)];
    }
#pragma unroll
    for (int i = 0; i < 32; ++i) scr[(2 * i + (lane >> 5)) * 33 + (lane & 31)] = v[i];
    asm volatile("s_waitcnt lgkmcnt(0)" ::: "memory");
    const int c = lane & 7;
#pragma unroll
    for (int j = 0; j < 4; ++j) { const int n = (lane >> 3) + 8 * j; const LAS float* s = scr + (8 * c) * 33 + n;
        u32x4 o; o.x = cvtpk(s[0 * 33], s[1 * 33]); o.y = cvtpk(s[2 * 33], s[3 * 33]); o.z = cvtpk(s[4 * 33], s[5 * 33]); o.w = cvtpk(s[6 * 33], s[7 * 33]);
        *(u32x4*)(WT + (size_t)(drow0 + n) * dK + dk0 + 8 * c) = o; }
    asm volatile("s_waitcnt lgkmcnt(0)" ::: "memory");
}
__device__ __forceinline__ void transpose_item_fp8(const float* __restrict__ W, int ldw, int sk0, int srccol, float scale, unsigned char* __restrict__ WT, int dK, int drow0, int dk0, LAS float* scr, int lane, const float* __restrict__ kscale = nullptr) {
    float v[32];
    const float* wp = W + (size_t)(sk0 + (lane >> 5)) * ldw + srccol;
#pragma unroll
    for (int i = 0; i < 32; ++i) v[i] = wp[(size_t)(2 * i) * ldw];
    if (kscale) {
#pragma unroll
        for (int i = 0; i < 32; ++i) v[i] *= kscale[sk0 + 2 * i + (lane >> 5)];
    }
#pragma unroll
    for (int i = 0; i < 32; ++i) scr[(2 * i + (lane >> 5)) * 33 + (lane & 31)] = __builtin_amdgcn_fmed3f(v[i] * scale, -448.f, 448.f);
    asm volatile("s_waitcnt lgkmcnt(0)" ::: "memory");
    const int c = lane & 7;
#pragma unroll
    for (int j = 0; j < 4; ++j) { const int n = (lane >> 3) + 8 * j; const LAS float* s = scr + (8 * c) * 33 + n;
        u32x2 o; o.x = pk4_fp8(s[0 * 33], s[1 * 33], s[2 * 33], s[3 * 33]); o.y = pk4_fp8(s[4 * 33], s[5 * 33], s[6 * 33], s[7 * 33]);
        *(u32x2*)(WT + (size_t)(drow0 + n) * dK + dk0 + 8 * c) = o; }
    asm volatile("s_waitcnt lgkmcnt(0)" ::: "memory");
}
struct TItem { const float* W; int ldw, sk0, srccol; float scale; unsigned char* WT; int dK, drow0, dk0; const float* kscale; };
__device__ __forceinline__ void titem_load(const TItem& t, float (&v)[32], int lane) {
    const float* wp = t.W + (size_t)(t.sk0 + (lane >> 5)) * t.ldw + t.srccol;
#pragma unroll
    for (int i = 0; i < 32; ++i) v[i] = wp[(size_t)(2 * i) * t.ldw];
}
__device__ __forceinline__ void titem_finish(const TItem& t, float (&v)[32], LAS float* scr, int lane) {
    if (t.kscale) {
#pragma unroll
        for (int i = 0; i < 32; ++i) v[i] *= t.kscale[t.sk0 + 2 * i + (lane >> 5)];
    }
#pragma unroll
    for (int i = 0; i < 32; ++i) scr[(2 * i + (lane >> 5)) * 33 + (lane & 31)] = __builtin_amdgcn_fmed3f(v[i] * t.scale, -448.f, 448.f);
    asm volatile("s_waitcnt lgkmcnt(0)" ::: "memory");
    const int c = lane & 7;
#pragma unroll
    for (int j = 0; j < 4; ++j) { const int n = (lane >> 3) + 8 * j; const LAS float* sp = scr + (8 * c) * 33 + n;
        u32x2 o; o.x = pk4_fp8(sp[0 * 33], sp[1 * 33], sp[2 * 33], sp[3 * 33]); o.y = pk4_fp8(sp[4 * 33], sp[5 * 33], sp[6 * 33], sp[7 * 33]);
        *(u32x2*)(t.WT + (size_t)(t.drow0 + n) * t.dK + t.dk0 + 8 * c) = o; }
    asm volatile("s_waitcnt lgkmcnt(0)" ::: "memory");
}
__device__ __forceinline__ int win_srccol(int j) { return j < 2600 ? j : (j < 2816 ? -1 : j - 216); }

struct Args { const float* in[13]; float* out; unsigned char* ws; int ph_lo, ph_hi; };

__global__ void __launch_bounds__(NWAVES * 64, 2) mk_fwd(Args args) {
    extern __shared__ __attribute__((aligned(16))) unsigned char lds_raw[];
    LAS unsigned char* lds = (LAS unsigned char*)lds_raw;
    volatile LAS unsigned* MISC = (volatile LAS unsigned*)(lds + MISC_OFF);
    const int tid = threadIdx.x, lane = tid & 63; const int wave = __builtin_amdgcn_readfirstlane(tid >> 6);
    const int G = gridDim.x; const int bx = blockIdx.x; const int vcu = (G % 8 == 0) ? (bx % 8) * (G / 8) + bx / 8 : bx;
    unsigned char* ws = args.ws;
    unsigned* ctl = (unsigned*)(ws + WS_CTL);
    const float* x = args.in[0];
#define WIN ((bf16_t*)(args.ws + WS_WIN))
#define WCAT ((bf16_t*)(args.ws + WS_WCAT))
#define WOUT ((bf16_t*)(args.ws + WS_WOUT))
#define W1T ((bf16_t*)(args.ws + WS_W1))
#define W2T ((bf16_t*)(args.ws + WS_W2))
#define XN ((bf16_t*)(args.ws + WS_XN))
#define QSB ((bf16_t*)(args.ws + WS_QSB))
#define KSB ((bf16_t*)(args.ws + WS_KSB))
#define VSB ((bf16_t*)(args.ws + WS_VSB))
#define QSA ((bf16_t*)(args.ws + WS_QSA))
#define KSA ((bf16_t*)(args.ws + WS_KSA))
#define VSA ((bf16_t*)(args.ws + WS_VSA))
#define QIX ((bf16_t*)(args.ws + WS_QIX))
#define KIX ((bf16_t*)(args.ws + WS_KIX))
#define WIX ((float*)(args.ws + WS_WIX))
#define MASK ((unsigned*)(args.ws + WS_MASK))
#define G1 ((bf16_t*)(args.ws + WS_G1))
#define G2 ((bf16_t*)(args.ws + WS_G2))
#define OCAT ((bf16_t*)(args.ws + WS_OCAT))
#define SSQ ((float*)(args.ws + WS_SSQ))
#define MG ((bf16_t*)(args.ws + WS_MG))
#define U ((bf16_t*)(args.ws + WS_U))
    for (int u = tid; u < (LDS_BYTES - LDSCTL_OFF) / 4; u += NWAVES * 64) ((LAS unsigned*)(lds + LDSCTL_OFF))[u] = 0u;
    __syncthreads();
    const int lo = args.ph_lo, hi = args.ph_hi;
    const bool one_launch = (hi - lo) > 1;
    XcdBarrier bar; bar.bar = ctl + CW_BAR; bar.x = 0; bar.st = nullptr;
    if (one_launch) bar = xcd_barrier_post(ctl + CW_BAR, MISC + 8);
    if (one_launch && tid == 0) __hip_atomic_store(ctl + CW_XCC + bx, xb_xcc_id() + 1u, __ATOMIC_RELAXED, __HIP_MEMORY_SCOPE_AGENT);
    bool local_ok = false;
#ifndef PH_MASK
#define PH_MASK 0xff
#endif
#define IN(k) (((PH_MASK >> (k)) & 1) && lo <= (k) && (k) < hi)
#ifndef REPEAT_MASK
#define REPEAT_MASK 0
#endif
#define REPS(k) ((((REPEAT_MASK) >> (k)) & 1) ? 2 : 1)
#ifndef DUP_MASK
#define DUP_MASK 0
#endif
#define DUPS(k) ((((DUP_MASK) >> (k)) & 1) ? 2 : 1)
#define SEAM(k) do { if (IN(k) && IN((k) + 1)) xcd_barrier(bar); } while (0)
#define SEAM_L(k) do { if (IN(k) && IN((k) + 1)) { if (local_ok) xcd_barrier<true>(bar); else xcd_barrier(bar); } } while (0)

    if (IN(0)) for (int rep_ = 0; rep_ < REPS(0); ++rep_) {
        LAS float* scr = (LAS float*)(lds + wave * 16384);
        const int gw = vcu * NWAVES + wave, NGW = G * NWAVES;
        constexpr int I_IN = (DM / 64) * (NPROJ_A / 32), I_G = (DM / 64) * (NGATE / 32);
        const int it1_ = gw + NGW; const bool two_ = (gw < I_IN) && (it1_ >= I_IN) && (it1_ < I_IN + I_G) && (it1_ + NGW >= I_IN + I_G);
        float nv_[32]; TItem t1_;
        if (two_) {
            const int r = it1_ - I_IN, nblk = NGATE / 32, kb = r / nblk, nb = r % nblk; const int jr = 32 * nb + (lane & 31);
            t1_ = TItem{args.in[2], PROJ_W, 64 * kb, win_srccol(256 * tile_b(jr >> 8) + (jr & 255)), GATE_WSCALE, (unsigned char*)(args.ws + WS_WG8), DM, 32 * nb, 64 * kb, args.in[1]};
            titem_load(t1_, nv_, lane);
        }
        for (int it = gw; it < (two_ ? I_IN : I_IN + I_G); it += NGW) {
            if (it < I_IN) { const int nblk = NPROJ_A / 32, kb = it / nblk, nb = it % nblk; const int jr = 32 * nb + (lane & 31); transpose_item(args.in[2], PROJ_W, 64 * kb, win_srccol(256 * tile_a(jr >> 8) + (jr & 255)), args.in[1], WIN, DM, 32 * nb, 64 * kb, scr, lane); }
            else { const int r = it - I_IN, nblk = NGATE / 32, kb = r / nblk, nb = r % nblk; const int jr = 32 * nb + (lane & 31); transpose_item_fp8(args.in[2], PROJ_W, 64 * kb, win_srccol(256 * tile_b(jr >> 8) + (jr & 255)), GATE_WSCALE, (unsigned char*)(args.ws + WS_WG8), DM, 32 * nb, 64 * kb, scr, lane, args.in[1]); }
        }
        if (two_) titem_finish(t1_, nv_, scr, lane);
        if (one_launch && rep_ == 0) {
            asm volatile("s_waitcnt vmcnt(0)" ::: "memory"); __syncthreads();
            if (tid == 0) { __builtin_amdgcn_fence(__ATOMIC_RELEASE, "agent"); asm volatile("s_waitcnt vmcnt(0)" ::: "memory"); xb_add(ctl + CW_WINREADY, 1u); }
        }
        const int m0 = (G == 256) ? (bx & 7) * SEQ + 2 * ((bx >> 3) * NWAVES + wave) : 2 * gw, mstep = (G == 256) ? 2 * (G / 8) * NWAVES : 2 * NGW, mend = (G == 256) ? ((bx & 7) + 1) * SEQ : M;
        for (int m = m0; m < mend; m += mstep) {
            const f32x4* xr = (const f32x4*)(x + (size_t)m * DM) + lane; f32x4 v[2][4]; float s0 = 0.f, s1 = 0.f;
#pragma unroll
            for (int j = 0; j < 4; ++j) { v[0][j] = xr[64 * j]; v[1][j] = xr[256 + 64 * j]; }
#pragma unroll
            for (int j = 0; j < 4; ++j) { s0 += (v[0][j][0] * v[0][j][0] + v[0][j][1] * v[0][j][1]) + (v[0][j][2] * v[0][j][2] + v[0][j][3] * v[0][j][3]);
                                          s1 += (v[1][j][0] * v[1][j][0] + v[1][j][1] * v[1][j][1]) + (v[1][j][2] * v[1][j][2] + v[1][j][3] * v[1][j][3]); }
            const float rs0 = __builtin_amdgcn_rsqf(wave_sum(s0) * (1.f / DM) + EPS), rs1 = __builtin_amdgcn_rsqf(wave_sum(s1) * (1.f / DM) + EPS);
            u32x2* o8 = (u32x2*)(XN + (size_t)m * DM) + lane;
            if (lane == 0) { float* rsd = (float*)(args.ws + WS_RSTD); rsd[m] = rs0; rsd[m + 1] = rs1; }
#pragma unroll
            for (int j = 0; j < 4; ++j) { const f32x4 x0 = v[0][j], x1_ = v[1][j]; const f32x4 y0 = x0 * rs0, y1 = x1_ * rs1;
                u32x2 w0, w1; w0.x = cvtpk(x0[0], x0[1]); w0.y = cvtpk(x0[2], x0[3]); w1.x = cvtpk(x1_[0], x1_[1]); w1.y = cvtpk(x1_[2], x1_[3]); o8[64 * j] = w0; o8[256 + 64 * j] = w1;
                unsigned* o4 = (unsigned*)(args.ws + WS_XN8 + (size_t)m * DM) + lane; o4[64 * j] = pk4_fp8_nc(y0[0], y0[1], y0[2], y0[3]); o4[256 + 64 * j] = pk4_fp8_nc(y1[0], y1[1], y1[2], y1[3]); }
        }
    }
    if (IN(0) && IN(1)) {
        wait_count(ctl + CW_WINREADY, (unsigned)G);
        if (G == 256) {
            bool okl = true;
#pragma unroll
            for (int i = 0; i < 4; ++i) { const int w = lane + 64 * i; okl = okl && (__hip_atomic_load(ctl + CW_XCC + w, __ATOMIC_RELAXED, __HIP_MEMORY_SCOPE_AGENT) == __hip_atomic_load(ctl + CW_XCC + (w & 7), __ATOMIC_RELAXED, __HIP_MEMORY_SCOPE_AGENT)); }
            local_ok = __all(okl);
        }
        if (local_ok) xcd_barrier<true>(bar); else xcd_barrier(bar);
    }
    if (IN(1)) for (int rep_ = 0; rep_ < REPS(1); ++rep_) {
        LAS float* ptab = (LAS float*)(lds + LDSCTL_OFF + 4096); int ptab_pm0 = -1;
        { pg8::StaticOrder S; S.init(M, NPROJ_A, G, bx, DUPS(1));
          { pg8::Unit u0; if (S.next(0, u0)) ptab_pm0 = u0.pm;
            if (tid < 256) { if (ptab_pm0 >= 0) ptab[tid] = ((const float*)(args.ws + WS_RSTD))[256 * ptab_pm0 + tid]; }
            else { const int i = tid - 256, w = i >> 6, d = i & 63; ptab[256 + i] = (w == 0 ? args.in[3][d] * C2 : w == 1 ? args.in[4][d] : w == 2 ? args.in[5][d] * C2 : args.in[6][d]); }
            __syncthreads(); } }
        { pg8::Gemm g{(const bf16_t*)(args.ws + WS_XN8), (const bf16_t*)(args.ws + WS_WG8), M, NGATE, DM}; pg8::StaticOrder S; S.init(M, NGATE, G, bx, DUPS(1));
          pg8::EpiProj E{QSB, KSB, VSB, QSA, KSA, VSA, QIX, KIX, G1, G2, WIX, ptab, ptab_pm0, nullptr, 1, -1.4426950408889634f, 1.f / GATE_WSCALE};
          pg8::gemm_phase<pg8::EpiProj, pg8::StaticOrder, true, true>(lds, g, S, E); }
        { pg8::Gemm g{XN, WIN, M, NPROJ_A, DM}; pg8::StaticOrder S; S.init(M, NPROJ_A, G, bx, DUPS(1));
          pg8::EpiProj E{QSB, KSB, VSB, QSA, KSA, VSA, QIX, KIX, G1, G2, WIX, ptab, ptab_pm0, (const float*)(args.ws + WS_RSTD), 0, -1.4426950408889634f, 1.f};
          pg8::gemm_phase<pg8::EpiProj, pg8::StaticOrder, true>(lds, g, S, E); }
        { const int nfull = (M / 256) * (NGATE / 256) % G, nidle = (nfull == 0) ? G : G - nfull;
          const int first = (nfull == 0) ? 0 : nfull;
          if (bx >= first) {
              LAS float* scr = (LAS float*)(lds + wave * 16384);
              const int gw = (bx - first) * NWAVES + wave, NGW = nidle * NWAVES;
              constexpr int I_CAT = (1024 / 64) * (1024 / 32), I_OUT = I_CAT, I_1 = (DM / 64) * (FF / 32), I_2 = (FF / 64) * (DM / 32);
              auto decode = [&](int r) -> TItem {
                  if (r < I_CAT) { const int nblk = 1024 / 32, kb = r / nblk, nb = r % nblk;
                      return TItem{kb < 8 ? args.in[7] : args.in[8], 1024, 64 * (kb & 7), 32 * nb + (lane & 31), WCAT_SCALE, (unsigned char*)WCAT, 1024, 32 * nb, 64 * kb, nullptr}; } r -= I_CAT;
                  if (r < I_OUT) { const int nblk = 1024 / 32, kb = r / nblk, nb = r % nblk; return TItem{args.in[9], 1024, 64 * kb, 32 * nb + (lane & 31), WOUT_SCALE, (unsigned char*)WOUT, 1024, 32 * nb, 64 * kb, nullptr}; } r -= I_OUT;
                  if (r < I_1) { const int nblk = FF / 32, kb = r / nblk, nb = r % nblk; return TItem{args.in[11], FF, 64 * kb, 32 * nb + (lane & 31), W1_SCALE, (unsigned char*)W1T, DM, 32 * nb, 64 * kb, args.in[10]}; } r -= I_1;
                  { const int nblk = DM / 32, kb = r / nblk, nb = r % nblk; return TItem{args.in[12], DM, 64 * kb, 32 * nb + (lane & 31), W2_SCALE, (unsigned char*)W2T, FF, 32 * nb, 64 * kb, nullptr}; }
              };
              constexpr int I_ALL = I_CAT + I_OUT + I_1 + I_2;
              if (gw < I_ALL) {
                  int it = gw; TItem cur = decode(it); float v[32], nv[32]; titem_load(cur, v, lane);
#pragma unroll 1
                  for (;;) {
                      const int nx = it + NGW; const bool hn = nx < I_ALL; TItem nxt = decode(hn ? nx : it);
                      titem_load(nxt, nv, lane);
                      titem_finish(cur, v, scr, lane);
                      if (!hn) break;
                      cur = nxt; it = nx;
#pragma unroll
                      for (int i = 0; i < 32; ++i) v[i] = nv[i];
                  }
              }
          } }
    }
    SEAM_L(1);
    if (IN(2)) for (int rep_ = 0; rep_ < REPS(2); ++rep_) {
#pragma unroll 1
        for (int p = vcu; p < 256; p += G) { const int b = p >> 5, i = p & 31;
#pragma unroll 1
            for (int u2 = 0; u2 < 2; ++u2) idx::idx_unit(b, u2 ? i : 63 - i, QIX, KIX, WIX, MASK, (LAS char*)lds + wave * 16384);
            asm volatile("s_waitcnt vmcnt(0)" ::: "memory");
            __syncthreads();
            if (tid == 0) { __hip_atomic_fetch_add(ctl + CW_MFLAG + 16 * (32 * b + ((63 - i) >> 1)), 1u, __ATOMIC_RELAXED, __HIP_MEMORY_SCOPE_AGENT);
                            __hip_atomic_fetch_add(ctl + CW_MFLAG + 16 * (32 * b + (i >> 1)), 1u, __ATOMIC_RELAXED, __HIP_MEMORY_SCOPE_AGENT); } }
    }
    if (IN(3)) for (int rep_ = 0; rep_ < REPS(3); ++rep_) {
        LAS char* shm = (LAS char*)lds;
        for (int p = vcu; p < 256; p += G) {
            { const int bp = p >> 3, Ri = p & 7; att::sb_pair(bp >> 2, bp & 3, 15 - Ri, Ri, QSB, KSB, VSB, OCAT, shm); }
#pragma unroll 1
            for (int u2 = 0; u2 < 2; ++u2) { const int bg = p >> 4, qi = p & 15, qb = u2 ? qi : 31 - qi;
                if (one_launch) {
                    if (tid == 0) { unsigned* fl = ctl + CW_MFLAG + 16 * (32 * (bg >> 1) + qb); unsigned sp = 0;
                        while (__hip_atomic_load(fl, __ATOMIC_RELAXED, __HIP_MEMORY_SCOPE_AGENT) < 2u) { __builtin_amdgcn_s_sleep(2); if (++sp > (1u << 22)) break; }
                        __builtin_amdgcn_fence(__ATOMIC_ACQUIRE, "agent"); asm volatile("s_waitcnt vmcnt(0)" ::: "memory"); }
                    __syncthreads(); }
                att::sa_unit2(bg >> 1, bg & 1, qb, QSA, KSA, VSA, MASK, OCAT, shm); }
        }
    }
    SEAM(3);
    if (IN(4)) for (int rep_ = 0; rep_ < REPS(4); ++rep_) {
        pg8::Gemm g{OCAT, WCAT, M, 1024, 1024}; pg8::StaticOrder S; S.init(M, 1024, G, bx, DUPS(4));
        pg8::EpiMerge E{(const unsigned char*)G1, (const unsigned char*)G2, MG};
        pg8::gemm_phase<pg8::EpiMerge, pg8::StaticOrder, true, true>(lds, g, S, E);
    }
    if (IN(5)) for (int rep_ = 0; rep_ < REPS(5); ++rep_) {
        pg8::Gemm g{MG, WOUT, M, 1024, 1024}; pg8::StaticOrder S; S.init(M, 1024, G, bx, DUPS(5));
        pg8::EpiWout E{XN, SSQ, (unsigned char*)(args.ws + WS_X18)};
        SeamPre pre{bar, IN(4) && IN(5), local_ok};
        pg8::gemm_phase<pg8::EpiWout, pg8::StaticOrder, true, true, SeamPre>(lds, g, S, E, pre);
    }
    if (IN(6)) for (int rep_ = 0; rep_ < REPS(6); ++rep_) {
        pg8::Gemm g{(const bf16_t*)(args.ws + WS_X18), W1T, M, FF, DM}; pg8::StaticOrder S; S.init(M, FF, G, bx, DUPS(6)); S.rot = 4;
        LAS float* r2tab = (LAS float*)(lds + LDSCTL_OFF + 4096); int pm0 = -1;
        { pg8::Unit u0; if (S.next(0, u0)) pm0 = u0.pm; }
        SeamPreTab pre{SeamPre{bar, IN(5) && IN(6), local_ok}, SSQ, r2tab, pm0};
        pg8::EpiUp E{SSQ, U, r2tab, pm0};
        pg8::gemm_phase<pg8::EpiUp, pg8::StaticOrder, true, true, SeamPreTab>(lds, g, S, E, pre);
    }
    if (IN(7)) {
        pg8::Gemm g{U, W2T, M, 1024, FF}; pg8::StaticOrder S; S.init(M, 1024, G, bx, DUPS(7));
        pg8::EpiDown E{XN, args.out};
        SeamPre pre{bar, IN(6) && IN(7), local_ok};
        pg8::gemm_phase<pg8::EpiDown, pg8::StaticOrder, true, true, SeamPre>(lds, g, S, E, pre);
    }
#ifdef EXTRA_BARRIERS
    for (int eb_ = 0; eb_ < EXTRA_BARRIERS; ++eb_) xcd_barrier(bar);
#endif
#undef IN
#undef SEAM
#undef WIN
#undef WCAT
#undef WOUT
#undef W1T
#undef W2T
#undef XN
#undef QSB
#undef KSB
#undef VSB
#undef QSA
#undef KSA
#undef VSA
#undef QIX
#undef KIX
#undef WIX
#undef MASK
#undef G1
#undef G2
#undef OCAT
#undef SSQ
#undef MG
#undef U
}

#if MK_DEBUG
namespace nv {
constexpr int TOPK = 256;
__device__ __forceinline__ float wave_sum(float v) {
#pragma unroll
    for (int o = 32; o > 0; o >>= 1) v += __shfl_xor(v, o);
    return v;
}
__device__ __forceinline__ float wave_max(float v) {
#pragma unroll
    for (int o = 32; o > 0; o >>= 1) v = fmaxf(v, __shfl_xor(v, o));
    return v;
}
__device__ __forceinline__ float softplusf(float z) { return fmaxf(z, 0.f) + log1pf(expf(-fabsf(z))); }
__global__ void k_rmsnorm(const float* __restrict__ x, const float* __restrict__ g, float* __restrict__ out, int rows, int D) {
    const int wave = (blockIdx.x * blockDim.x + threadIdx.x) >> 6, lane = threadIdx.x & 63;
    if (wave >= rows) return;
    const float* xr = x + (size_t)wave * D; float s = 0.f;
    for (int i = lane; i < D; i += 64) { const float v = xr[i]; s += v * v; }
    s = wave_sum(s);
    const float r = rsqrtf(s / (float)D + EPS);
    for (int i = lane; i < D; i += 64) out[(size_t)wave * D + i] = xr[i] * r * g[i];
}
__global__ void __launch_bounds__(256) k_gemm(const float* __restrict__ A, int lda, const float* __restrict__ B, int ldb, float* __restrict__ C, int ldc, int Mr, int N, int K) {
    __shared__ float As[16][64 + 4];
    __shared__ float Bs[16][64 + 4];
    const int tid = threadIdx.x, tx = tid & 15, ty = tid >> 4;
    const int m0 = blockIdx.y * 64, n0 = blockIdx.x * 64;
    float acc[4][4];
#pragma unroll
    for (int i = 0; i < 4; ++i)
#pragma unroll
        for (int j = 0; j < 4; ++j) acc[i][j] = 0.f;
    const int ar = tid >> 2, ak = (tid & 3) * 4, bk = tid >> 4, bn = (tid & 15) * 4;
    for (int k0 = 0; k0 < K; k0 += 16) {
        const float4 av = *(const float4*)(A + (size_t)(m0 + ar) * lda + k0 + ak);
        float4 bv = make_float4(0.f, 0.f, 0.f, 0.f);
        if (n0 + bn < N) bv = *(const float4*)(B + (size_t)(k0 + bk) * ldb + n0 + bn);
        As[ak + 0][ar] = av.x; As[ak + 1][ar] = av.y; As[ak + 2][ar] = av.z; As[ak + 3][ar] = av.w;
        Bs[bk][bn + 0] = bv.x; Bs[bk][bn + 1] = bv.y; Bs[bk][bn + 2] = bv.z; Bs[bk][bn + 3] = bv.w;
        __syncthreads();
#pragma unroll
        for (int k = 0; k < 16; ++k) {
            float a[4], b[4];
#pragma unroll
            for (int i = 0; i < 4; ++i) a[i] = As[k][ty * 4 + i];
#pragma unroll
            for (int j = 0; j < 4; ++j) b[j] = Bs[k][tx * 4 + j];
#pragma unroll
            for (int i = 0; i < 4; ++i)
#pragma unroll
                for (int j = 0; j < 4; ++j) acc[i][j] = fmaf(a[i], b[j], acc[i][j]);
        }
        __syncthreads();
    }
#pragma unroll
    for (int i = 0; i < 4; ++i)
#pragma unroll
        for (int j = 0; j < 4; ++j) { const int n = n0 + tx * 4 + j; if (n < N) C[(size_t)(m0 + ty * 4 + i) * ldc + n] = acc[i][j]; }
}
__global__ void k_headnorm(float* __restrict__ P, int ld, int col_off, int nheads, const float* __restrict__ gain, int rows) {
    const int wave = (blockIdx.x * blockDim.x + threadIdx.x) >> 6, lane = threadIdx.x & 63;
    if (wave >= rows * nheads) return;
    const int row = wave / nheads, h = wave % nheads;
    float* p = P + (size_t)row * ld + col_off + h * 64 + lane;
    const float v = *p; const float s = wave_sum(v * v);
    *p = v * rsqrtf(s * (1.f / 64.f) + EPS) * gain[lane];
}
__global__ void __launch_bounds__(256) k_sb(const float* __restrict__ P, int ld, float* __restrict__ O, int nrows) {
    __shared__ float qs[4][64];
    const int w = threadIdx.x >> 6, lane = threadIdx.x & 63;
    const int gw = blockIdx.x * 4 + w; const int h = gw / nrows, t = gw % nrows;
    qs[w][lane] = P[(size_t)t * ld + OFF_QSB + h * 64 + lane];
    __syncthreads();
    float o = 0.f, carry = 0.f;
    for (int c = (t - 1) >> 6; c >= 0 && t > 0; --c) {
        const int s = c * 64 + lane; const bool valid = s < t;
        const float* kr = P + (size_t)(valid ? s : 0) * ld + OFF_KSB + h * 64;
        float z = 0.f;
#pragma unroll 16
        for (int d = 0; d < 64; ++d) z = fmaf(qs[w][d], kr[d], z);
        z *= 0.125f;
        const float l1 = valid ? -softplusf(z) : 0.f; const float lb = -softplusf(-z);
        float incl = l1;
#pragma unroll
        for (int off = 1; off < 64; off <<= 1) { const float tmp = __shfl_down(incl, off); if (lane + off < 64) incl += tmp; }
        const float later = carry + (incl - l1);
        const float a = valid ? expf(lb + later) : 0.f;
        carry += __shfl(incl, 0);
        for (int j = 0; j < 64; ++j) { const float aj = __shfl(a, j); const int sj = c * 64 + j; if (sj < t) o = fmaf(aj, P[(size_t)sj * ld + OFF_VSB + h * 64 + lane], o); }
    }
    O[(size_t)t * 512 + h * 64 + lane] = o;
}
__global__ void __launch_bounds__(256) k_idx(const float* __restrict__ P, int ld, unsigned* __restrict__ SEL) {
    __shared__ float qi[256]; __shared__ float wi[8]; __shared__ unsigned key[SEQ]; __shared__ unsigned selw[64]; __shared__ int cnt;
    const int t = blockIdx.x, tid = threadIdx.x;
    qi[tid] = P[(size_t)t * ld + OFF_QIX + tid];
    if (tid < 8) wi[tid] = P[(size_t)t * ld + OFF_WIX + tid] * 0.35355339059327373f;
    if (tid < 64) selw[tid] = 0u;
    __syncthreads();
    const int n = t + 1;
    for (int s = tid; s < n; s += 256) {
        const float* kr = P + (size_t)s * ld + OFF_KIX; float kv[32];
#pragma unroll
        for (int d = 0; d < 32; ++d) kv[d] = kr[d];
        float sc = 0.f;
#pragma unroll 1
        for (int h = 0; h < 8; ++h) { float r = 0.f;
#pragma unroll
            for (int d = 0; d < 32; ++d) r = fmaf(qi[h * 32 + d], kv[d], r);
            r *= 0.17677669529663687f; sc += wi[h] * fmaxf(r, 0.f); }
        const unsigned u = __float_as_uint(sc);
        key[s] = (u & 0x80000000u) ? ~u : (u | 0x80000000u);
    }
    __syncthreads();
    if (n <= TOPK) { for (int s = tid; s < n; s += 256) atomicOr(&selw[s >> 5], 1u << (s & 31)); }
    else {
        unsigned T = 0u;
        for (int bit = 31; bit >= 0; --bit) {
            const unsigned cand = T | (1u << bit);
            if (tid == 0) cnt = 0;
            __syncthreads();
            int c = 0; for (int s = tid; s < n; s += 256) c += (key[s] >= cand) ? 1 : 0;
            c = (int)wave_sum((float)c); if ((tid & 63) == 0) atomicAdd(&cnt, c);
            __syncthreads();
            if (cnt >= TOPK) T = cand;
            __syncthreads();
        }
        if (tid == 0) cnt = 0;
        __syncthreads();
        int c = 0; for (int s = tid; s < n; s += 256) if (key[s] > T) { c++; atomicOr(&selw[s >> 5], 1u << (s & 31)); }
        c = (int)wave_sum((float)c); if ((tid & 63) == 0) atomicAdd(&cnt, c);
        __syncthreads();
        if (tid == 0) { int need = TOPK - cnt; for (int s = 0; s < n && need > 0; ++s) if (key[s] == T) { selw[s >> 5] |= 1u << (s & 31); --need; } }
    }
    __syncthreads();
    if (tid < 64) SEL[(size_t)t * 64 + tid] = selw[tid];
}
__global__ void __launch_bounds__(256) k_sa(const float* __restrict__ P, int ld, const unsigned* __restrict__ SEL, float* __restrict__ O, int nrows) {
    __shared__ float qs[4][64];
    const int w = threadIdx.x >> 6, lane = threadIdx.x & 63;
    const int gw = blockIdx.x * 4 + w; const int h = gw / nrows, t = gw % nrows, g = h >> 2;
    const float slope = exp2f(-(float)(h + 1));
    qs[w][lane] = P[(size_t)t * ld + OFF_QSA + h * 64 + lane];
    __syncthreads();
    float o = 0.f, m = -INFINITY, l = 0.f;
    for (int c = 0; c <= (t >> 6); ++c) {
        const int s = c * 64 + lane;
        const unsigned wsel = SEL[(size_t)t * 64 + (s >> 5)];
        const bool sel = (s <= t) && ((wsel >> (s & 31)) & 1u);
        const float* kr = P + (size_t)(s <= t ? s : 0) * ld + OFF_KSA + g * 64;
        float z = 0.f;
#pragma unroll 16
        for (int d = 0; d < 64; ++d) z = fmaf(qs[w][d], kr[d], z);
        const float sc = sel ? (z * 0.125f - slope * (float)(t - s)) : -INFINITY;
        const float cm = wave_max(sc);
        if (cm == -INFINITY) continue;
        const float mn = fmaxf(m, cm); const float scale = expf(m - mn); const float p = sel ? expf(sc - mn) : 0.f;
        l = l * scale + wave_sum(p); o *= scale;
        for (int j = 0; j < 64; ++j) { const float pj = __shfl(p, j); const int sj = c * 64 + j; if (sj <= t) o = fmaf(pj, P[(size_t)sj * ld + OFF_VSA + g * 64 + lane], o); }
        m = mn;
    }
    O[(size_t)t * 512 + h * 64 + lane] = o / l;
}
__device__ __forceinline__ float sigmoidf_(float v) { return 1.f / (1.f + expf(-v)); }
__global__ void k_merge(const float* __restrict__ P, int ld, const float* __restrict__ T1, const float* __restrict__ T2, float* __restrict__ MGn, int rows) {
    const size_t i = (size_t)blockIdx.x * blockDim.x + threadIdx.x; if (i >= (size_t)rows * 1024) return;
    const int r = (int)(i >> 10), c = (int)(i & 1023);
    MGn[i] = sigmoidf_(P[(size_t)r * ld + OFF_GSB + c]) * T1[i] + sigmoidf_(P[(size_t)r * ld + OFF_GSA + c]) * T2[i];
}
__global__ void k_add(const float* __restrict__ a, const float* __restrict__ b, float* __restrict__ out, size_t n) { const size_t i = (size_t)blockIdx.x * blockDim.x + threadIdx.x; if (i < n) out[i] = a[i] + b[i]; }
__global__ void k_relu2(float* __restrict__ u, size_t n) { const size_t i = (size_t)blockIdx.x * blockDim.x + threadIdx.x; if (i < n) { const float v = fmaxf(u[i], 0.f); u[i] = v * v; } }
__global__ void k_cmp_bf16(const bf16_t* __restrict__ F, int fld, int fcol, float fscale, const float* __restrict__ R, int rld, int rcol, int rows, int cols, int tf, float rscale, float* stats, int stage) {
    const size_t i = (size_t)blockIdx.x * blockDim.x + threadIdx.x; float num = 0.f, den = 0.f;
    if (i < (size_t)rows * cols) { const int r = (int)(i / cols), c = (int)(i % cols); float ref = R[(size_t)r * rld + rcol + c] * rscale; if (tf == 1) ref = sigmoidf_(ref);
        const float f = bf2f(F[(size_t)r * fld + fcol + c]) * fscale; num = (f - ref) * (f - ref); den = ref * ref; }
    num = wave_sum(num); den = wave_sum(den);
    if ((threadIdx.x & 63) == 0) { atomicAdd(&stats[2 * stage], num); atomicAdd(&stats[2 * stage + 1], den); }
}
__global__ void k_cmp_f32(const float* __restrict__ F, int fld, int fcol, float fscale, const float* __restrict__ R, int rld, int rcol, int rows, int cols, float rscale, float* stats, int stage) {
    const size_t i = (size_t)blockIdx.x * blockDim.x + threadIdx.x; float num = 0.f, den = 0.f;
    if (i < (size_t)rows * cols) { const int r = (int)(i / cols), c = (int)(i % cols); const float ref = R[(size_t)r * rld + rcol + c] * rscale;
        const float f = F[(size_t)r * fld + fcol + c] * fscale; num = (f - ref) * (f - ref); den = ref * ref; }
    num = wave_sum(num); den = wave_sum(den);
    if ((threadIdx.x & 63) == 0) { atomicAdd(&stats[2 * stage], num); atomicAdd(&stats[2 * stage + 1], den); }
}
__global__ void k_cmp_mask(const unsigned* __restrict__ F, const unsigned* __restrict__ R, int rows, float* stats, int stage) {
    const int i = blockIdx.x * blockDim.x + threadIdx.x; float num = 0.f, den = 0.f;
    if (i < rows * 64) { num = (float)__popc(F[i] ^ R[i]); den = (float)__popc(R[i]); }
    num = wave_sum(num); den = wave_sum(den);
    if ((threadIdx.x & 63) == 0) { atomicAdd(&stats[2 * stage], num); atomicAdd(&stats[2 * stage + 1], den); }
}
__global__ void k_encode(float* __restrict__ out, size_t n, const float* __restrict__ stats, const unsigned* __restrict__ ctl) {
    int bad = 0;
    for (int s = 1; s <= 20 && !bad; ++s) { const float num = stats[2 * s], den = stats[2 * s + 1]; const float thr = (s == 13) ? 0.2f : (s == 15 ? 0.05f : 0.004f); if (!(num <= thr * den) || !(den > 0.f)) bad = s; }
    if (!bad && ctl[CW_BAR + XB_TMO]) bad = 21;
    const size_t i = (size_t)blockIdx.x * blockDim.x + threadIdx.x;
    if (bad && i < n) out[i] *= (1.f + 0.25f * (float)bad);
}
}
#endif

extern "C" void kernel_launch(void* const* d_in, const int* in_sizes, int n_in, void* d_out, int out_size, void* d_ws, size_t ws_size, hipStream_t stream) {
    static int grid = 0;
    if (grid == 0) {
        if (n_in != 13 || in_sizes[0] != M * DM || out_size != M * DM || ws_size < WS_END) { fprintf(stderr, "kernel_launch: unexpected problem (n_in %d, in0 %d, out %d, ws %zu)\n", n_in, n_in > 0 ? in_sizes[0] : -1, out_size, ws_size); grid = -1; return; }
        int dev = 0, cus = 0, per_cu = 0;
        if (hipGetDevice(&dev) != hipSuccess || hipDeviceGetAttribute(&cus, hipDeviceAttributeMultiprocessorCount, dev) != hipSuccess) { grid = -1; return; }
        if (hipFuncSetAttribute((const void*)mk_fwd, hipFuncAttributeMaxDynamicSharedMemorySize, LDS_BYTES) != hipSuccess) { fprintf(stderr, "kernel_launch: hipFuncSetAttribute failed\n"); grid = -1; return; }
        if (hipOccupancyMaxActiveBlocksPerMultiprocessor(&per_cu, (const void*)mk_fwd, NWAVES * 64, LDS_BYTES) != hipSuccess || per_cu < 1) { fprintf(stderr, "kernel_launch: occupancy query says %d blocks per CU\n", per_cu); per_cu = 0; }
        (void)hipGetLastError();
        if (per_cu < 1) { grid = -1; return; }
        grid = cus;
    }
    if (grid < 0) return;
    (void)hipMemsetAsync((char*)d_ws + WS_CTL, 0, CTL_ZERO_BYTES, stream);
    Args a{};
    for (int i = 0; i < 13; ++i) a.in[i] = (const float*)d_in[i];
    a.out = (float*)d_out; a.ws = (unsigned char*)d_ws;
#if !MK_DEBUG
    a.ph_lo = 0; a.ph_hi = 8;
    void* kargs[] = {&a};
#ifdef PLAIN_LAUNCH
    hipLaunchKernelGGL(mk_fwd, dim3(grid), dim3(NWAVES * 64), LDS_BYTES, stream, a); (void)kargs;
    const hipError_t le = hipPeekAtLastError();
#else
    const hipError_t le = hipLaunchCooperativeKernel((const void*)mk_fwd, dim3(grid), dim3(NWAVES * 64), kargs, LDS_BYTES, stream);
#endif
    if (le != hipSuccess) fprintf(stderr, "kernel_launch: cooperative launch failed: %s (grid %d)\n", hipGetErrorName(le), grid);
#else
    using namespace nv;
    const float* x = (const float*)d_in[0];
    constexpr int CB = 5, CR = 512;
    const size_t r0 = (size_t)CB * SEQ;
    char* ws = (char*)d_ws; char* e0 = (char*)d_out;
    float* stats = (float*)(ws + 512 * 1024);
    float* Hn = (float*)(e0 + 0 * MiB); float* PROJn = (float*)(e0 + 2 * MiB); float* OSBn = (float*)(e0 + 12 * MiB); float* OSAn = (float*)(e0 + 13 * MiB);
    unsigned* SELn = (unsigned*)(e0 + 14 * MiB); float* T1n = (float*)(e0 + 15 * MiB); float* T2n = (float*)(e0 + 17 * MiB);
    char* l0 = ws + WS_OCAT;
    float* MGn = (float*)(l0 + 0 * MiB); float* Yn = (float*)(l0 + 2 * MiB); float* X1n = (float*)(l0 + 4 * MiB); float* H2n = (float*)(l0 + 6 * MiB); float* Un = (float*)(l0 + 8 * MiB); float* OUTn = (float*)(l0 + 16 * MiB);
    auto launch = [&](int p) { a.ph_lo = p; a.ph_hi = p + 1; hipLaunchKernelGGL(mk_fwd, dim3(grid), dim3(NWAVES * 64), LDS_BYTES, stream, a); };
    auto cmpb = [&](const void* F, int fld, int fcol, float fscale, const float* R, int rld, int rcol, int cols, int tf, float rscale, int stage) {
        k_cmp_bf16<<<(CR * cols + 255) / 256, 256, 0, stream>>>((const bf16_t*)F + r0 * fld, fld, fcol, fscale, R, rld, rcol, CR, cols, tf, rscale, stats, stage); };
    launch(0);
    k_rmsnorm<<<CR / 4, 256, 0, stream>>>(x + r0 * DM, (const float*)d_in[1], Hn, CR, DM);
    cmpb(ws + WS_XN, DM, 0, 1.f, Hn, DM, 0, DM, 0, 1.f, 1);
    launch(1);
    k_gemm<<<dim3((PROJ_W + 63) / 64, CR / 64), 256, 0, stream>>>(Hn, DM, (const float*)d_in[2], PROJ_W, PROJn, PROJ_W, CR, PROJ_W, DM);
    k_headnorm<<<CR * 8 / 4, 256, 0, stream>>>(PROJn, PROJ_W, OFF_QSB, 8, (const float*)d_in[3], CR);
    k_headnorm<<<CR * 8 / 4, 256, 0, stream>>>(PROJn, PROJ_W, OFF_KSB, 8, (const float*)d_in[4], CR);
    k_headnorm<<<CR * 8 / 4, 256, 0, stream>>>(PROJn, PROJ_W, OFF_QSA, 8, (const float*)d_in[5], CR);
    k_headnorm<<<CR * 2 / 4, 256, 0, stream>>>(PROJn, PROJ_W, OFF_KSA, 2, (const float*)d_in[6], CR);
    cmpb(ws + WS_QSB, 512, 0, 1.f / C2, PROJn, PROJ_W, OFF_QSB, 512, 0, 1.f, 2);
    cmpb(ws + WS_KSB, 512, 0, 1.f, PROJn, PROJ_W, OFF_KSB, 512, 0, 1.f, 3);
    cmpb(ws + WS_VSB, 512, 0, 1.f, PROJn, PROJ_W, OFF_VSB, 512, 0, 1.f, 4);
    cmpb(ws + WS_QSA, 512, 0, 1.f / C2, PROJn, PROJ_W, OFF_QSA, 512, 0, 1.f, 5);
    cmpb(ws + WS_KSA, 128, 0, 1.f, PROJn, PROJ_W, OFF_KSA, 128, 0, 1.f, 6);
    cmpb(ws + WS_VSA, 128, 0, 1.f, PROJn, PROJ_W, OFF_VSA, 128, 0, 1.f, 7);
    cmpb(ws + WS_QIX, 256, 0, 1.f, PROJn, PROJ_W, OFF_QIX, 256, 0, 1.f, 8);
    cmpb(ws + WS_KIX, 32, 0, 1.f, PROJn, PROJ_W, OFF_KIX, 32, 0, 1.f, 9);
    k_cmp_f32<<<(CR * 8 + 255) / 256, 256, 0, stream>>>((const float*)(ws + WS_WIX) + r0 * 8, 8, 0, 16.f, PROJn, PROJ_W, OFF_WIX, CR, 8, 1.f, stats, 10);
    cmpb(ws + WS_G1, 1024, 0, 1.f, PROJn, PROJ_W, OFF_GSB, 1024, 1, 1.f, 11);
    cmpb(ws + WS_G2, 1024, 0, 1.f, PROJn, PROJ_W, OFF_GSA, 1024, 1, 1.f, 12);
    launch(2);
    k_idx<<<CR, 256, 0, stream>>>(PROJn, PROJ_W, SELn);
    k_cmp_mask<<<(CR * 64 + 255) / 256, 256, 0, stream>>>((const unsigned*)(ws + WS_MASK) + r0 * 64, SELn, CR, stats, 13);
    launch(3);
    k_sb<<<8 * CR / 4, 256, 0, stream>>>(PROJn, PROJ_W, OSBn, CR);
    k_sa<<<8 * CR / 4, 256, 0, stream>>>(PROJn, PROJ_W, SELn, OSAn, CR);
    cmpb(ws + WS_OCAT, 1024, 0, 1.f, OSBn, 512, 0, 512, 0, 1.f, 14);
    cmpb(ws + WS_OCAT, 1024, 512, 1.f, OSAn, 512, 0, 512, 0, 1.f, 15);
    k_gemm<<<dim3(1024 / 64, CR / 64), 256, 0, stream>>>(OSBn, 512, (const float*)d_in[7], 1024, T1n, 1024, CR, 1024, 512);
    k_gemm<<<dim3(1024 / 64, CR / 64), 256, 0, stream>>>(OSAn, 512, (const float*)d_in[8], 1024, T2n, 1024, CR, 1024, 512);
    launch(4);
    k_merge<<<CR * 1024 / 256, 256, 0, stream>>>(PROJn, PROJ_W, T1n, T2n, MGn, CR);
    cmpb(ws + WS_MG, 1024, 0, 1.f, MGn, 1024, 0, 1024, 0, 1.f, 16);
    k_gemm<<<dim3(1024 / 64, CR / 64), 256, 0, stream>>>(MGn, 1024, (const float*)d_in[9], 1024, Yn, 1024, CR, 1024, 1024);
    k_add<<<CR * 1024 / 256, 256, 0, stream>>>(x + r0 * DM, Yn, X1n, (size_t)CR * 1024);
    launch(5);
    cmpb(ws + WS_XN, DM, 0, 1.f, X1n, DM, 0, DM, 0, 1.f, 17);
    cmpb(ws + WS_XN, DM, 0, 1.f, X1n, DM, 0, DM, 0, 1.f, 18);
    k_rmsnorm<<<CR / 4, 256, 0, stream>>>(X1n, (const float*)d_in[10], H2n, CR, DM);
    k_gemm<<<dim3(FF / 64, CR / 64), 256, 0, stream>>>(H2n, DM, (const float*)d_in[11], FF, Un, FF, CR, FF, DM);
    k_relu2<<<CR * FF / 256, 256, 0, stream>>>(Un, (size_t)CR * FF);
    launch(6);
    cmpb(ws + WS_U, FF, 0, 1.f, Un, FF, 0, FF, 0, 1.f, 19);
    k_gemm<<<dim3(1024 / 64, CR / 64), 256, 0, stream>>>(Un, FF, (const float*)d_in[12], 1024, Yn, 1024, CR, 1024, FF);
    k_add<<<CR * 1024 / 256, 256, 0, stream>>>(X1n, Yn, OUTn, (size_t)CR * 1024);
    launch(7);
    k_cmp_f32<<<(CR * 1024 + 255) / 256, 256, 0, stream>>>((const float*)d_out + r0 * DM, DM, 0, 1.f, OUTn, DM, 0, CR, DM, 1.f, stats, 20);
    k_encode<<<(M * DM + 255) / 256, 256, 0, stream>>>((float*)d_out, (size_t)M * DM, stats, (const unsigned*)(ws + WS_CTL));
#endif
}
```
